# Optimizing an MI355X kernel written in HIP

```python
import math
import jax, jax.numpy as jnp
from jax import lax
import numpy as np

D_MODEL = 1024
BATCH = 8
SEQ = 2048
DEPTH = 1
DEC_BATCH = 128
DEC_SEQ = 4
PAST_LEN = 16384
PAGE_SIZE = 128

N_META = 16
D_FF = 2816
GLA_HEADS = 4
GLA_DK = D_MODEL // (2 * GLA_HEADS)
GLA_DV = D_MODEL // GLA_HEADS
GLA_GATE_RANK = 16
GLA_GATE_TAU = 16.0
GLA_CHUNK = 64
S5_WIDTH = D_MODEL
S5_GROUP = 16
S5_GROUPS = S5_WIDTH // S5_GROUP
S5_STATE = 64
EPS = 1e-6
IN_SPLITS = (GLA_HEADS * GLA_DK, GLA_HEADS * GLA_DK, GLA_HEADS * GLA_DV, GLA_HEADS * GLA_DV,
             GLA_GATE_RANK, S5_WIDTH, D_MODEL, D_MODEL)
IN_COLS = sum(IN_SPLITS)

kernel_name = "gla_s5_gated_hybrid_step"

F32 = jnp.float32


def _rmsnorm(x, gain):
    x32 = x.astype(F32)
    y = x32 * lax.rsqrt(jnp.mean(x32 * x32, axis=-1, keepdims=True) + EPS)
    return (y * gain.astype(F32)).astype(x.dtype)


def _swiglu(x, w_gate, w_up, w_down):
    return (jax.nn.silu(x @ w_gate) * (x @ w_up)) @ w_down


def _gla_chunked(q, k, v, g, s0, chunk):
    bsz, nh, L, dk = q.shape
    dv = v.shape[-1]
    n = L // chunk
    q = q.reshape(bsz, nh, n, chunk, dk)
    k = k.reshape(bsz, nh, n, chunk, dk)
    v = v.reshape(bsz, nh, n, chunk, dv)
    g = g.reshape(bsz, nh, n, chunk, dk)
    b = jnp.cumsum(g, axis=3)
    b_last = b[:, :, :, -1:, :]
    qe = q * jnp.exp(b)
    ke = k * jnp.exp(-b)
    kd = k * jnp.exp(b_last - b)
    mask = jnp.tril(jnp.ones((chunk, chunk), dtype=bool))
    scores = jnp.einsum('bhncd,bhnsd->bhncs', qe, ke)
    o_intra = jnp.einsum('bhncs,bhnse->bhnce', jnp.where(mask, scores, 0.0), v)
    chunk_kv = jnp.einsum('bhnsd,bhnse->bhnde', kd, v)
    decay = jnp.exp(b_last[:, :, :, 0, :])

    def step(s, inp):
        dec, kv = inp
        return dec[..., None] * s + kv, s

    s_final, s_in = lax.scan(step, s0, (jnp.moveaxis(decay, 2, 0), jnp.moveaxis(chunk_kv, 2, 0)))
    s_in = jnp.moveaxis(s_in, 0, 2)
    o_inter = jnp.einsum('bhncd,bhnde->bhnce', qe, s_in)
    return (o_intra + o_inter).reshape(bsz, nh, L, dv), s_final


def _lin_comb(left, right):
    a1, b1 = left
    a2, b2 = right
    return a1 * a2, a2 * b1 + b2


def _s5(u, s_re, s_im, p):
    bsz, L, _ = u.shape
    uc = u.astype(F32).reshape(bsz, L, S5_GROUPS, S5_GROUP)
    lam = lax.complex(p["s5_a_re"].astype(F32), p["s5_a_im"].astype(F32))
    dt = jnp.exp(p["s5_log_dt"].astype(F32))[:, None]
    a_bar = jnp.exp(lam * dt)
    b_bar = ((a_bar - 1.0) / lam)[:, :, None] * lax.complex(p["s5_b_re"].astype(F32), p["s5_b_im"].astype(F32))
    c = lax.complex(p["s5_c_re"].astype(F32), p["s5_c_im"].astype(F32))
    bu = jnp.einsum('blgc,gpc->blgp', uc.astype(jnp.complex64), b_bar)
    h0 = lax.complex(s_re.astype(F32), s_im.astype(F32))
    bu = bu.at[:, 0].add(a_bar * h0)
    a_seq = jnp.broadcast_to(a_bar, bu.shape)
    _, hs = lax.associative_scan(_lin_comb, (a_seq, bu), axis=1)
    y = jnp.real(jnp.einsum('gcp,blgp->blgc', c, hs)) + p["s5_d"].astype(F32) * uc
    return y.reshape(bsz, L, S5_WIDTH), hs[:, -1]


def _layer(h, s_gla, s5_re, s5_im, segments, p):
    bsz, L, _ = h.shape
    dt = h.dtype
    h = h + 0.5 * _swiglu(_rmsnorm(h, p["norm_ffn1"]), p["ffn1_w_gate"], p["ffn1_w_up"], p["ffn1_w_down"])
    u = _rmsnorm(h, p["norm_mix"])
    z = u @ p["w_in"]
    offsets = []
    acc = 0
    for w in IN_SPLITS[:-1]:
        acc += w
        offsets.append(acc)
    q, k, v, r, g_lr, u_s5, gate_a, gate_b = jnp.split(z, offsets, axis=-1)

    g = jax.nn.log_sigmoid((g_lr @ p["gla_w_gate_up"] + p["gla_b_gate"]).astype(F32)) / GLA_GATE_TAU

    def heads(x, d):
        return x.reshape(bsz, L, GLA_HEADS, d).transpose(0, 2, 1, 3).astype(F32)

    qh = heads(q, GLA_DK) * (GLA_DK ** -0.5)
    kh = heads(k, GLA_DK)
    vh = heads(v, GLA_DV)
    gh = heads(g, GLA_DK)
    s = s_gla.astype(F32)
    outs = []
    start = 0
    for seg_len, chunk in segments:
        sl = slice(start, start + seg_len)
        o_seg, s = _gla_chunked(qh[:, :, sl], kh[:, :, sl], vh[:, :, sl], gh[:, :, sl], s, chunk)
        outs.append(o_seg)
        start += seg_len
    o = jnp.concatenate(outs, axis=2)
    o = o * lax.rsqrt(jnp.mean(o * o, axis=-1, keepdims=True) + EPS)
    o = o.transpose(0, 2, 1, 3).reshape(bsz, L, GLA_HEADS * GLA_DV) * p["gla_norm"].astype(F32)
    gla_out = (o.astype(dt) * jax.nn.silu(r)) @ p["gla_w_out"]

    y5, h5_last = _s5(u_s5, s5_re, s5_im, p)
    y5 = jax.nn.gelu(y5).astype(dt)
    s5_out = (y5 @ p["s5_w_glu_a"]) * jax.nn.sigmoid(y5 @ p["s5_w_glu_b"])

    merged = jax.nn.sigmoid(gate_a) * gla_out + jax.nn.sigmoid(gate_b) * s5_out
    h = h + merged @ p["w_out"]
    h = h + 0.5 * _swiglu(_rmsnorm(h, p["norm_ffn2"]), p["ffn2_w_gate"], p["ffn2_w_up"], p["ffn2_w_down"])
    return (h, s.astype(s_gla.dtype), jnp.real(h5_last).astype(s5_re.dtype),
            jnp.imag(h5_last).astype(s5_im.dtype))


def setup_inputs(seed: int = 0) -> dict:
    key = jax.random.key(seed)
    ks = iter(jax.random.split(key, 48))

    def nrm(shape, scale):
        return jax.random.normal(next(ks), shape, F32) * scale

    def gain(shape):
        return 1.0 + nrm(shape, 0.01)

    Dp = DEPTH
    d = {}
    d["x_prompt"] = nrm((BATCH, SEQ, D_MODEL), 1.0)
    d["x_sample"] = nrm((DEC_BATCH, DEC_SEQ, D_MODEL), 1.0)
    d["state_gla"] = nrm((Dp, DEC_BATCH, GLA_HEADS, GLA_DK, GLA_DV), 0.5)
    d["state_s5_re"] = nrm((Dp, DEC_BATCH, S5_GROUPS, S5_STATE), 0.1)
    d["state_s5_im"] = nrm((Dp, DEC_BATCH, S5_GROUPS, S5_STATE), 0.1)
    d["meta_tokens"] = nrm((N_META, D_MODEL), 1.0)
    d["norm_ffn1"] = gain((Dp, D_MODEL))
    d["ffn1_w_gate"] = nrm((Dp, D_MODEL, D_FF), D_MODEL ** -0.5)
    d["ffn1_w_up"] = nrm((Dp, D_MODEL, D_FF), D_MODEL ** -0.5)
    d["ffn1_w_down"] = nrm((Dp, D_FF, D_MODEL), D_FF ** -0.5)
    d["norm_mix"] = gain((Dp, D_MODEL))
    d["w_in"] = nrm((Dp, D_MODEL, IN_COLS), D_MODEL ** -0.5)
    d["gla_w_gate_up"] = nrm((Dp, GLA_GATE_RANK, GLA_HEADS * GLA_DK), GLA_GATE_RANK ** -0.5)
    d["gla_b_gate"] = nrm((Dp, GLA_HEADS * GLA_DK), 0.1)
    d["gla_norm"] = gain((Dp, GLA_HEADS * GLA_DV))
    d["gla_w_out"] = nrm((Dp, GLA_HEADS * GLA_DV, D_MODEL), (GLA_HEADS * GLA_DV) ** -0.5)
    d["s5_a_re"] = -0.5 + nrm((Dp, S5_GROUPS, S5_STATE), 0.01)
    d["s5_a_im"] = jnp.pi * jnp.arange(S5_STATE, dtype=F32) + nrm((Dp, S5_GROUPS, S5_STATE), 0.01)
    d["s5_log_dt"] = jax.random.uniform(next(ks), (Dp, S5_GROUPS), F32,
                                        minval=math.log(0.001), maxval=math.log(0.1))
    d["s5_b_re"] = nrm((Dp, S5_GROUPS, S5_STATE, S5_GROUP), (2 * S5_GROUP) ** -0.5)
    d["s5_b_im"] = nrm((Dp, S5_GROUPS, S5_STATE, S5_GROUP), (2 * S5_GROUP) ** -0.5)
    d["s5_c_re"] = nrm((Dp, S5_GROUPS, S5_GROUP, S5_STATE), (2 * S5_STATE) ** -0.5)
    d["s5_c_im"] = nrm((Dp, S5_GROUPS, S5_GROUP, S5_STATE), (2 * S5_STATE) ** -0.5)
    d["s5_d"] = nrm((Dp, S5_GROUPS, S5_GROUP), 1.0)
    d["s5_w_glu_a"] = nrm((Dp, S5_WIDTH, D_MODEL), S5_WIDTH ** -0.5)
    d["s5_w_glu_b"] = nrm((Dp, S5_WIDTH, D_MODEL), S5_WIDTH ** -0.5)
    d["w_out"] = nrm((Dp, D_MODEL, D_MODEL), D_MODEL ** -0.5)
    d["norm_ffn2"] = gain((Dp, D_MODEL))
    d["ffn2_w_gate"] = nrm((Dp, D_MODEL, D_FF), D_MODEL ** -0.5)
    d["ffn2_w_up"] = nrm((Dp, D_MODEL, D_FF), D_MODEL ** -0.5)
    d["ffn2_w_down"] = nrm((Dp, D_FF, D_MODEL), D_FF ** -0.5)
    d["norm_final"] = gain((D_MODEL,))
    return d


def reference(x_prompt, x_sample, state_gla, state_s5_re, state_s5_im, meta_tokens,
              norm_ffn1, ffn1_w_gate, ffn1_w_up, ffn1_w_down, norm_mix, w_in,
              gla_w_gate_up, gla_b_gate, gla_norm, gla_w_out,
              s5_a_re, s5_a_im, s5_log_dt, s5_b_re, s5_b_im, s5_c_re, s5_c_im, s5_d,
              s5_w_glu_a, s5_w_glu_b, w_out, norm_ffn2, ffn2_w_gate, ffn2_w_up, ffn2_w_down,
              norm_final):
    layer_params = dict(
        norm_ffn1=norm_ffn1, ffn1_w_gate=ffn1_w_gate, ffn1_w_up=ffn1_w_up, ffn1_w_down=ffn1_w_down,
        norm_mix=norm_mix, w_in=w_in, gla_w_gate_up=gla_w_gate_up, gla_b_gate=gla_b_gate,
        gla_norm=gla_norm, gla_w_out=gla_w_out, s5_a_re=s5_a_re, s5_a_im=s5_a_im,
        s5_log_dt=s5_log_dt, s5_b_re=s5_b_re, s5_b_im=s5_b_im, s5_c_re=s5_c_re, s5_c_im=s5_c_im,
        s5_d=s5_d, s5_w_glu_a=s5_w_glu_a, s5_w_glu_b=s5_w_glu_b, w_out=w_out,
        norm_ffn2=norm_ffn2, ffn2_w_gate=ffn2_w_gate, ffn2_w_up=ffn2_w_up, ffn2_w_down=ffn2_w_down)
    bsz = x_prompt.shape[0]
    dt = x_prompt.dtype
    meta = jnp.broadcast_to(meta_tokens.astype(dt)[None], (bsz, N_META, D_MODEL))
    h_p = jnp.concatenate([meta, x_prompt], axis=1)
    h_s = x_sample
    prompt_segments = ((N_META, N_META), (SEQ, GLA_CHUNK))
    sample_segments = ((DEC_SEQ, DEC_SEQ),)
    gla_p, re_p, im_p, gla_s, re_s, im_s = [], [], [], [], [], []
    for layer in range(DEPTH):
        p = {name: w[layer] for name, w in layer_params.items()}
        zero_gla = jnp.zeros((bsz, GLA_HEADS, GLA_DK, GLA_DV), state_gla.dtype)
        zero_s5 = jnp.zeros((bsz, S5_GROUPS, S5_STATE), state_s5_re.dtype)
        h_p, sg, sr, si = _layer(h_p, zero_gla, zero_s5, zero_s5, prompt_segments, p)
        gla_p.append(sg); re_p.append(sr); im_p.append(si)
        h_s, sg, sr, si = _layer(h_s, state_gla[layer], state_s5_re[layer], state_s5_im[layer],
                                 sample_segments, p)
        gla_s.append(sg); re_s.append(sr); im_s.append(si)
    y_prompt = _rmsnorm(h_p[:, N_META:], norm_final)
    y_sample = _rmsnorm(h_s, norm_final)
    return (y_prompt, y_sample, jnp.stack(gla_p), jnp.stack(re_p), jnp.stack(im_p),
            jnp.stack(gla_s), jnp.stack(re_s), jnp.stack(im_s))
```

```cpp
#include <hip/hip_runtime.h>
#include <cstdio>
#include <cstdint>

#define LAS __attribute__((address_space(3)))
#define GAS __attribute__((address_space(1)))
typedef unsigned short bf16_t;
typedef short bf16x8 __attribute__((ext_vector_type(8)));
typedef float f32x2 __attribute__((ext_vector_type(2)));
typedef float f32x4 __attribute__((ext_vector_type(4)));
typedef float f32x16 __attribute__((ext_vector_type(16)));
typedef unsigned u32x2 __attribute__((ext_vector_type(2)));
typedef unsigned u32x4 __attribute__((ext_vector_type(4)));
typedef GAS unsigned gu32;

#ifndef MK_PER_PHASE
#define MK_PER_PHASE 0
#endif

constexpr int D = 1024, FF = 2816, NBATCH = 8, SEQ = 2048, DECB = 128, DECS = 4, NMETA = 16;
constexpr int NH = 4, DK = 128, DV = 256, GRANK = 16, S5G = 64, S5C = 16, S5P = 64;
constexpr int R_PROMPT = NBATCH * SEQ;
constexpr int R_SAMPLE = DECB * DECS;
constexpr int R_TOK = R_PROMPT + R_SAMPLE;
constexpr int R_META = R_TOK;
constexpr int R_ALL = R_TOK + NMETA;
constexpr int R_PAD = 17152;
constexpr int ZC = 4096, ZQ = 0, ZK = 512, ZV = 1024, ZR = 2048, ZU = 3072;
constexpr int NWIN = 6400;
constexpr float EPS = 1e-6f;
constexpr size_t O_YP = 0, O_YS = 16777216, O_GLAP = 17301504, O_S5RP = 18350080, O_S5IP = 18382848, O_GLAS = 18415616, O_S5RS = 35192832, O_S5IS = 35717120, O_END = 36241408;
constexpr size_t WS_CTL = 0, CTL_ZERO_BYTES = 65536;
constexpr size_t WS_SSQ = 65536;
constexpr size_t WS_GLR = WS_SSQ + (size_t)R_PAD * 16 * 4;
constexpr size_t WS_ABAR = WS_GLR + (size_t)R_ALL * 16 * 4;
constexpr size_t WS_BBAR = WS_ABAR + 64 * 64 * 2 * 4;
constexpr size_t WS_W = 2883584;
constexpr size_t WS_WT1 = WS_W, WS_WD1 = WS_WT1 + (size_t)5632 * 1024 * 2, WS_WIN = WS_WD1 + (size_t)1024 * 2816 * 2, WS_WGO = WS_WIN + (size_t)NWIN * 1024 * 2,
                 WS_WGLU = WS_WGO + (size_t)1024 * 1024 * 2, WS_WO = WS_WGLU + (size_t)2048 * 1024 * 2, WS_WT2 = WS_WO + (size_t)1024 * 1024 * 2, WS_WD2 = WS_WT2 + (size_t)5632 * 1024 * 2;
constexpr size_t WS_REGA = WS_WD2 + (size_t)1024 * 2816 * 2;
constexpr size_t WS_REGB = WS_REGA + (size_t)R_ALL * ZC * 2;
constexpr size_t WS_END = WS_REGB + (size_t)R_TOK * 2048 * 2;
static_assert(WS_BBAR + 64 * 64 * 32 * 4 <= WS_W, "small tables");
static_assert((size_t)R_PAD * FF * 2 <= (size_t)R_ALL * ZC * 2, "HID fits REGA");
static_assert(WS_END <= 268435456, "workspace map must fit 256 MiB");
constexpr int CW_BAR = 4096;
constexpr int LDS_BYTES = 147456, MISC_OFF = 143360;

#define LDS_WAIT() asm volatile("s_waitcnt lgkmcnt(0)" ::: "memory")
#define VM_WAIT() asm volatile("s_waitcnt vmcnt(0)" ::: "memory")
__device__ __forceinline__ unsigned f2bf(float f) { unsigned u = __builtin_bit_cast(unsigned, f); return (u + 0x7fffu + ((u >> 16) & 1u)) >> 16; }
__device__ __forceinline__ unsigned pk2(float lo, float hi) { return f2bf(lo) | (f2bf(hi) << 16); }
__device__ __forceinline__ float bf2f(unsigned short h) { return __builtin_bit_cast(float, (unsigned)h << 16); }
__device__ __forceinline__ float bflo(unsigned w) { return __builtin_bit_cast(float, w << 16); }
__device__ __forceinline__ float bfhi(unsigned w) { return __builtin_bit_cast(float, w & 0xffff0000u); }
__device__ __forceinline__ float fast_exp(float x) { return __builtin_amdgcn_exp2f(x * 1.44269504089f); }
__device__ __forceinline__ float sigmoidf(float x) { return __builtin_amdgcn_rcpf(1.0f + fast_exp(-x)); }
__device__ __forceinline__ float siluf(float x) { return x * sigmoidf(x); }
__device__ __forceinline__ float gelu_tanh(float x) { const float u = 0.7978845608f * (x + 0.044715f * x * x * x); return x * sigmoidf(2.0f * u); }
__device__ __forceinline__ float wave_sum(float v) {
#pragma unroll
    for (int o = 1; o < 64; o <<= 1) v += __shfl_xor(v, o);
    return v;
}

namespace pg8 {
constexpr int BM = 256, BK = 64, HALF = 128, HTB = HALF * BK * 2, STAGE_BYTES = 8 * HTB, NXCD = 8, WGM = 8;
__host__ __device__ __forceinline__ int lds_byte(int r, int c) { const int st = (r >> 4) * 2 + (c >> 5), rr = r & 15, cc = c & 31, ob = rr * 64 + cc * 2; return st * 1024 + (ob ^ (((ob >> 9) & 1) << 5)); }
__host__ __device__ __forceinline__ void stage_rc(int b, int& R, int& C) { const int st = b / 1024, sb = b % 1024, swz = sb ^ (((sb >> 9) & 1) << 5); R = (st >> 1) * 16 + swz / 64; C = (st & 1) * 32 + (swz % 64) / 2; }
__host__ __device__ __forceinline__ int perm32(int rho) { const int n = rho >> 4, i = rho & 15; return 8 * (i >> 2) + 4 * n + (i & 3); }

struct Unit { int pm, pn; };
struct Gemm { const bf16_t* A; const bf16_t* Bt; int M, N, K, lda; };

struct StaticOrder {
    int nM, nN, nwg, G, c;
    __device__ void init(int M, int N, int G_, int c_) { nM = M / BM; nN = N / BM; nwg = nM * nN; G = G_; c = c_; }
    __device__ bool next(int i, Unit& u) const {
        const long L = (long)i * G + c; if (L >= nwg) return false;
        int wgid = (int)L; { const int q = nwg / NXCD, r = nwg % NXCD, xcd = wgid % NXCD, off = wgid / NXCD; wgid = (xcd < r ? xcd * (q + 1) : r * (q + 1) + (xcd - r) * q) + off; }
        const int nig = WGM * nN, gid = wgid / nig, fm = gid * WGM, gsz = (nM - fm) < WGM ? (nM - fm) : WGM;
        u.pm = fm + ((wgid % nig) % gsz); u.pn = (wgid % nig) / gsz; return true;
    }
};

template <class Epi>
__device__ __forceinline__ void gemm_phase(LAS unsigned char* lds, const Gemm g, const StaticOrder& S, const Epi& E) {
    const int tid = threadIdx.x, wid = __builtin_amdgcn_readfirstlane(tid >> 6), lane = tid & 63, wr = wid >> 2, wc = wid & 3, fr = lane & 15, fq = lane >> 4;
    const int K = g.K, nt = K / BK;
    unsigned voffA[2], voffB[2];
#pragma unroll
    for (int i = 0; i < 2; ++i) { int R, C; stage_rc(tid * 16 + i * 8192, R, C); const int Rb = (R & ~31) + perm32(R & 31);
        voffA[i] = (unsigned)(R * g.lda + C) * 2u; voffB[i] = (unsigned)(Rb * K + C) * 2u; }
    const size_t kstep = (size_t)(BK * 2);
    const size_t hstepA = (size_t)HALF * g.lda * 2, tstepA = 2 * hstepA;
    const size_t hstepB = (size_t)HALF * K * 2, tstepB = 2 * hstepB;
    const unsigned ldsw = (unsigned)wid * 1024u;
    const int aoff = lds_byte(wr * 64 + fr, fq * 8), boff = lds_byte(wc * 32 + fr, fq * 8);
#define PG8_SA(b, h) (((b) * 2 + (h)) * HTB)
#define PG8_SB(b, h) ((4 + (b) * 2 + (h)) * HTB)
#define PG8_STAGE(bufoff, gbase, voff) do { _Pragma("unroll") for (int _i = 0; _i < 2; ++_i) \
        __builtin_amdgcn_global_load_lds((const unsigned*)((const char*)(gbase) + (voff)[_i]), (LAS unsigned*)(lds + (bufoff) + ldsw + _i * 8192), 16, 0, 0); } while (0)
#define PG8_LDA(dst, b, h) do { _Pragma("unroll") for (int m = 0; m < 4; ++m) _Pragma("unroll") for (int k = 0; k < 2; ++k) dst[m][k] = *(const LAS bf16x8*)(lds + PG8_SA(b, h) + aoff + m * 2048 + k * 1024); } while (0)
#define PG8_LDB(dst, b, h) do { _Pragma("unroll") for (int n = 0; n < 2; ++n) _Pragma("unroll") for (int k = 0; k < 2; ++k) dst[n][k] = *(const LAS bf16x8*)(lds + PG8_SB(b, h) + boff + n * 2048 + k * 1024); } while (0)
#define PG8_MMA(ai, bj, At, Bt) do { __builtin_amdgcn_s_setprio(1); _Pragma("unroll") for (int m = 0; m < 4; ++m) _Pragma("unroll") for (int n = 0; n < 2; ++n) _Pragma("unroll") for (int k = 0; k < 2; ++k) \
        acc[ai][bj][m][n] = __builtin_amdgcn_mfma_f32_16x16x32_bf16(Bt[n][k], At[m][k], acc[ai][bj][m][n], 0, 0, 0); __builtin_amdgcn_s_setprio(0); } while (0)
#define PG8_WAIT_V(n) asm volatile("s_waitcnt vmcnt(" #n ")" ::: "memory")
#define PG8_WAIT_L(n) asm volatile("s_waitcnt lgkmcnt(" #n ")" ::: "memory")
#define PG8_BAR __builtin_amdgcn_s_barrier()
#define PG8_SCHED __builtin_amdgcn_sched_barrier(0)
    Unit cur, nxt; int ui = 0;
    if (!S.next(0, cur)) return;
    f32x4 acc[2][2][4][2];
#pragma unroll
    for (int a = 0; a < 2; ++a)
#pragma unroll
        for (int b = 0; b < 2; ++b)
#pragma unroll
            for (int m = 0; m < 4; ++m)
#pragma unroll
                for (int n = 0; n < 2; ++n) acc[a][b][m][n] = (f32x4){0.f, 0.f, 0.f, 0.f};
    bf16x8 At[4][2], B0[2][2], B1[2][2];
    const char* cA = (const char*)g.A + (size_t)cur.pm * tstepA; const char* cB = (const char*)g.Bt + (size_t)cur.pn * tstepB;
    PG8_STAGE(PG8_SB(0, 0), cB, voffB); PG8_STAGE(PG8_SB(0, 1), cB + hstepB, voffB); PG8_STAGE(PG8_SA(0, 0), cA, voffA); PG8_STAGE(PG8_SA(0, 1), cA + hstepA, voffA);
    if (wr == 1) PG8_BAR;
    PG8_WAIT_V(2); PG8_BAR;
    PG8_STAGE(PG8_SB(1, 0), cB + kstep, voffB); PG8_STAGE(PG8_SA(1, 0), cA + kstep, voffA); PG8_STAGE(PG8_SB(1, 1), cB + hstepB + kstep, voffB);
    PG8_WAIT_V(6); PG8_BAR;
    for (;;) {
        const bool has_next = S.next(ui + 1, nxt);
        const char* nA = has_next ? (const char*)g.A + (size_t)nxt.pm * tstepA : cA; const char* nB = has_next ? (const char*)g.Bt + (size_t)nxt.pn * tstepB : cB;
        for (int t = 0; t < nt; t += 2) {
            const bool last = (t == nt - 2);
            const char* a1 = cA + (size_t)(t + 1) * kstep;
            const char* a2 = last ? nA : cA + (size_t)(t + 2) * kstep; const char* b2 = last ? nB : cB + (size_t)(t + 2) * kstep;
            const char* a3 = a2 + kstep; const char* b3 = b2 + kstep;
            PG8_LDB(B0, 0, 0); PG8_LDB(B1, 0, 1); PG8_SCHED; PG8_LDA(At, 0, 0); PG8_STAGE(PG8_SA(1, 1), a1 + hstepA, voffA);
            PG8_WAIT_V(8); PG8_WAIT_L(0); PG8_BAR; PG8_MMA(0, 0, At, B0); PG8_MMA(0, 1, At, B1); PG8_BAR; PG8_SCHED;
            PG8_LDA(At, 0, 1); PG8_STAGE(PG8_SB(0, 0), b2, voffB); PG8_STAGE(PG8_SB(0, 1), b2 + hstepB, voffB); PG8_STAGE(PG8_SA(0, 0), a2, voffA);
            PG8_WAIT_V(8); PG8_WAIT_L(0); PG8_BAR; PG8_MMA(1, 0, At, B0); PG8_MMA(1, 1, At, B1); PG8_BAR; PG8_SCHED;
            PG8_LDB(B0, 1, 0); PG8_LDB(B1, 1, 1); PG8_SCHED; PG8_LDA(At, 1, 0); PG8_STAGE(PG8_SA(0, 1), a2 + hstepA, voffA);
            PG8_WAIT_V(8); PG8_WAIT_L(0); PG8_BAR; PG8_MMA(0, 0, At, B0); PG8_MMA(0, 1, At, B1); PG8_BAR; PG8_SCHED;
            PG8_LDA(At, 1, 1); PG8_STAGE(PG8_SB(1, 0), b3, voffB); PG8_STAGE(PG8_SB(1, 1), b3 + hstepB, voffB); PG8_STAGE(PG8_SA(1, 0), a3, voffA);
            PG8_WAIT_V(8); PG8_WAIT_L(0); PG8_BAR; PG8_MMA(1, 0, At, B0); PG8_MMA(1, 1, At, B1); PG8_BAR; PG8_SCHED;
        }
        if (wr == 0) PG8_BAR;
        E(acc, cur, wr, wc, fr, fq);
        if (!has_next) break;
#pragma unroll
        for (int a = 0; a < 2; ++a)
#pragma unroll
            for (int b = 0; b < 2; ++b)
#pragma unroll
                for (int m = 0; m < 4; ++m)
#pragma unroll
                    for (int n = 0; n < 2; ++n) acc[a][b][m][n] = (f32x4){0.f, 0.f, 0.f, 0.f};
        cur = nxt; cA = nA; cB = nB; ++ui;
        if (wr == 1) PG8_BAR;
    }
    PG8_WAIT_V(0);
    PG8_BAR;
#undef PG8_SA
#undef PG8_SB
#undef PG8_STAGE
#undef PG8_LDA
#undef PG8_LDB
#undef PG8_MMA
#undef PG8_WAIT_V
#undef PG8_WAIT_L
#undef PG8_BAR
#undef PG8_SCHED
}

__device__ __forceinline__ float row_rstd(const float* ssq, int row) {
    const f32x4* p = (const f32x4*)(ssq + (size_t)row * 16); const f32x4 a = p[0], b = p[1], c = p[2], d = p[3];
    const float s = ((a.x + a.y) + (a.z + a.w)) + ((b.x + b.y) + (b.z + b.w)) + ((c.x + c.y) + (c.z + c.w)) + ((d.x + d.y) + (d.z + d.w));
    return __builtin_amdgcn_rsqf(s * (1.0f / 1024.0f) + EPS);
}
struct EpiGU {
    bf16_t* O; int ldo; const float* ssq;
    __device__ __forceinline__ void operator()(const f32x4 (&acc)[2][2][4][2], const Unit& u, int wr, int wc, int fr, int fq) const {
        const int col0 = u.pn * 128 + wc * 32 + 8 * fq;
#pragma unroll
        for (int ai = 0; ai < 2; ++ai)
#pragma unroll
            for (int m = 0; m < 4; ++m) { const int row = u.pm * BM + ai * HALF + wr * 64 + m * 16 + fr; const float rs = row_rstd(ssq, row);
                u32x4 w; unsigned* wp = (unsigned*)&w;
#pragma unroll
                for (int n = 0; n < 2; ++n) { const f32x4 gt = acc[ai][0][m][n] * rs, up = acc[ai][1][m][n] * rs;
                    wp[2 * n] = pk2(siluf(gt[0]) * up[0], siluf(gt[1]) * up[1]); wp[2 * n + 1] = pk2(siluf(gt[2]) * up[2], siluf(gt[3]) * up[3]); }
                *(u32x4*)(O + (size_t)row * ldo + col0) = w; }
    }
};
struct EpiRes {
    int mode;
    const float* xp; const float* xs; const float* meta; float* H; bf16_t* XB; float* ssq; float alpha;
    __device__ __forceinline__ void operator()(const f32x4 (&acc)[2][2][4][2], const Unit& u, int wr, int wc, int fr, int fq) const {
#pragma unroll
        for (int ai = 0; ai < 2; ++ai)
#pragma unroll
            for (int m = 0; m < 4; ++m) { const int row = u.pm * BM + ai * HALF + wr * 64 + m * 16 + fr;
                const float* bp;
                if (mode == 1) bp = H + (size_t)row * D;
                else bp = row < R_PROMPT ? xp + (size_t)row * D : row < R_TOK ? xs + (size_t)(row - R_PROMPT) * D : row < R_ALL ? meta + (size_t)(row - R_TOK) * D : nullptr;
                float ss = 0.f;
#pragma unroll
                for (int bj = 0; bj < 2; ++bj) { const int col = u.pn * BM + bj * HALF + wc * 32 + 8 * fq; f32x4 o[2];
#pragma unroll
                    for (int n = 0; n < 2; ++n) { const f32x4 b = bp ? *(const f32x4*)(bp + col + 4 * n) : (f32x4){0.f, 0.f, 0.f, 0.f}; o[n] = b + acc[ai][bj][m][n] * alpha;
                        if (row < R_TOK) *(f32x4*)(H + (size_t)row * D + col + 4 * n) = o[n];
                        ss += (o[n][0] * o[n][0] + o[n][1] * o[n][1]) + (o[n][2] * o[n][2] + o[n][3] * o[n][3]); }
                    if (XB) { u32x4 w; w.x = pk2(o[0][0], o[0][1]); w.y = pk2(o[0][2], o[0][3]); w.z = pk2(o[1][0], o[1][1]); w.w = pk2(o[1][2], o[1][3]); *(u32x4*)(XB + (size_t)row * D + col) = w; } }
                ss += __shfl_xor(ss, 16); ss += __shfl_xor(ss, 32);
                if (fq == 0) ssq[(size_t)row * 16 + u.pn * 4 + wc] = ss; }
    }
};
struct EpiZ {
    bf16_t* Z; bf16_t* G; float* GLR; const float* ssq;
    __device__ __forceinline__ void operator()(const f32x4 (&acc)[2][2][4][2], const Unit& u, int wr, int wc, int fr, int fq) const {
        const int pn = u.pn;
#pragma unroll
        for (int ai = 0; ai < 2; ++ai)
#pragma unroll
            for (int m = 0; m < 4; ++m) { const int row = u.pm * BM + ai * HALF + wr * 64 + m * 16 + fr; const float rs = row_rstd(ssq, row);
                if (pn == 24) {
                    if (wc == 0 && fq < 2 && row < R_ALL) { *(f32x4*)(GLR + (size_t)row * 16 + 8 * fq) = acc[ai][0][m][0] * rs; *(f32x4*)(GLR + (size_t)row * 16 + 8 * fq + 4) = acc[ai][0][m][1] * rs; }
                    continue; }
#pragma unroll
                for (int bj = 0; bj < 2; ++bj) { f32x4 v0 = acc[ai][bj][m][0] * rs, v1 = acc[ai][bj][m][1] * rs;
                    if (pn < 2) { v0 = v0 * 0.08838834764831845f; v1 = v1 * 0.08838834764831845f; }
                    else if (pn >= 8 && pn < 12) {
#pragma unroll
                        for (int j = 0; j < 4; ++j) { v0[j] = siluf(v0[j]); v1[j] = siluf(v1[j]); } }
                    else if (pn >= 16) {
#pragma unroll
                        for (int j = 0; j < 4; ++j) { v0[j] = sigmoidf(v0[j]); v1[j] = sigmoidf(v1[j]); } }
                    u32x4 w; w.x = pk2(v0[0], v0[1]); w.y = pk2(v0[2], v0[3]); w.z = pk2(v1[0], v1[1]); w.w = pk2(v1[2], v1[3]);
                    const int cc = bj * HALF + wc * 32 + 8 * fq;
                    if (pn < 16) { if (row < R_ALL) *(u32x4*)(Z + (size_t)row * ZC + pn * BM + cc) = w; }
                    else { if (row < R_TOK) *(u32x4*)(G + (size_t)row * 2048 + (pn - 16) * BM + cc) = w; } } }
    }
};
struct EpiGLU {
    const bf16_t* G; bf16_t* TMP;
    __device__ __forceinline__ void operator()(const f32x4 (&acc)[2][2][4][2], const Unit& u, int wr, int wc, int fr, int fq) const {
        const int col0 = u.pn * 128 + wc * 32 + 8 * fq;
#pragma unroll
        for (int ai = 0; ai < 2; ++ai)
#pragma unroll
            for (int m = 0; m < 4; ++m) { const int row = u.pm * BM + ai * HALF + wr * 64 + m * 16 + fr;
                const u32x4 gb = *(const u32x4*)(G + (size_t)row * 2048 + 1024 + col0); const unsigned* gp = (const unsigned*)&gb;
                u32x4 w; unsigned* wp = (unsigned*)&w;
#pragma unroll
                for (int n = 0; n < 2; ++n) { const f32x4 a = acc[ai][0][m][n], b = acc[ai][1][m][n];
                    wp[2 * n] = pk2(a[0] * sigmoidf(b[0]) * bflo(gp[2 * n]), a[1] * sigmoidf(b[1]) * bfhi(gp[2 * n]));
                    wp[2 * n + 1] = pk2(a[2] * sigmoidf(b[2]) * bflo(gp[2 * n + 1]), a[3] * sigmoidf(b[3]) * bfhi(gp[2 * n + 1])); }
                *(u32x4*)(TMP + (size_t)row * ZC + col0) = w; }
    }
};
struct EpiGO {
    const bf16_t* G; const bf16_t* TMP; bf16_t* MG;
    __device__ __forceinline__ void operator()(const f32x4 (&acc)[2][2][4][2], const Unit& u, int wr, int wc, int fr, int fq) const {
#pragma unroll
        for (int ai = 0; ai < 2; ++ai)
#pragma unroll
            for (int m = 0; m < 4; ++m) { const int row = u.pm * BM + ai * HALF + wr * 64 + m * 16 + fr;
#pragma unroll
                for (int bj = 0; bj < 2; ++bj) { const int col = u.pn * BM + bj * HALF + wc * 32 + 8 * fq;
                    const u32x4 ga = *(const u32x4*)(G + (size_t)row * 2048 + col), tp = *(const u32x4*)(TMP + (size_t)row * ZC + col);
                    const unsigned* gp = (const unsigned*)&ga; const unsigned* tpp = (const unsigned*)&tp; u32x4 w; unsigned* wp = (unsigned*)&w;
#pragma unroll
                    for (int n = 0; n < 2; ++n) { const f32x4 a = acc[ai][bj][m][n];
                        wp[2 * n] = pk2(a[0] * bflo(gp[2 * n]) + bflo(tpp[2 * n]), a[1] * bfhi(gp[2 * n]) + bfhi(tpp[2 * n]));
                        wp[2 * n + 1] = pk2(a[2] * bflo(gp[2 * n + 1]) + bflo(tpp[2 * n + 1]), a[3] * bfhi(gp[2 * n + 1]) + bfhi(tpp[2 * n + 1])); }
                    *(u32x4*)(MG + (size_t)row * ZC + col) = w; } }
    }
};
}

#define XB_TMO      128
#define XB_XCNT(j)  (256  + 64 * (j))
#define XB_XSUB(j)  (1280 + 64 * (j))
#define XB_XGEN(j)  (2304 + 64 * (j))
#define XB_TOP      3328
#define XB_TOPGEN   3392
#define XCD_BAR_WORDS 3456
#define XB_SPIN_CAP (1u << 18)
__device__ __forceinline__ unsigned xb_ld(unsigned* p)              { return __hip_atomic_load(p, __ATOMIC_RELAXED, __HIP_MEMORY_SCOPE_AGENT); }
__device__ __forceinline__ unsigned xb_add(unsigned* p, unsigned v) { return __hip_atomic_fetch_add(p, v, __ATOMIC_RELAXED, __HIP_MEMORY_SCOPE_AGENT); }
__device__ __forceinline__ unsigned xb_xcc_id() { return (unsigned)__builtin_amdgcn_s_getreg((3 << 11) | 20) & 0xFu; }
#define XB_SPIN(cond, bar) do { unsigned _sp = 0; while (cond) { __builtin_amdgcn_s_sleep(1); \
    if ((++_sp & 255u) == 0u) { if (xb_ld(&(bar)[XB_TMO])) break; if (_sp > XB_SPIN_CAP) { atomicAdd(&(bar)[XB_TMO], 1u); break; } } } } while (0)
struct XcdBarrier { unsigned* bar; unsigned x; volatile LAS unsigned* st; };
__device__ __forceinline__ XcdBarrier xcd_barrier_post(unsigned* bar, volatile LAS unsigned* st) {
    XcdBarrier b; b.bar = bar; b.x = xb_xcc_id(); b.st = st;
    if (threadIdx.x == 0) (void)xb_add(&bar[XB_XCNT(b.x)], 1u);
    return b;
}
__device__ __forceinline__ void xcd_barrier_complete(unsigned* bar, unsigned x, unsigned& nloc, unsigned& nx) {
    const unsigned G = gridDim.x * gridDim.y * gridDim.z;
    unsigned sum, cnt, mine, sp = 0u;
    for (;;) {
        sum = 0u; cnt = 0u; mine = 0u;
#pragma unroll
        for (unsigned j = 0; j < 16; ++j) { const unsigned c = xb_ld(&bar[XB_XCNT(j)]); sum += c; cnt += (c > 0u) ? 1u : 0u; mine = (j == x) ? c : mine; }
        if (sum == G) break;
        __builtin_amdgcn_s_sleep(1);
        if ((++sp & 255u) == 0u) { if (xb_ld(&bar[XB_TMO])) break; if (sp > XB_SPIN_CAP) { atomicAdd(&bar[XB_TMO], 1u); break; } }
    }
    nloc = mine > 0u ? mine : 1u; nx = cnt > 0u ? cnt : 1u;
}
__device__ __forceinline__ void xcd_barrier(const XcdBarrier& b) {
    asm volatile("s_waitcnt vmcnt(0)" ::: "memory");
    __syncthreads();
    if (threadIdx.x == 0) {
        unsigned* bar = b.bar;
        __builtin_amdgcn_s_waitcnt(0);
        unsigned nloc = b.st[0], nx = b.st[1];
        if (nloc == 0u) { xcd_barrier_complete(bar, b.x, nloc, nx); b.st[0] = nloc; b.st[1] = nx; }
        const unsigned old = xb_add(&bar[XB_XSUB(b.x)], 1u);
        const unsigned gen = old / nloc;
        if (old + 1u == (gen + 1u) * nloc) {
            __builtin_amdgcn_fence(__ATOMIC_RELEASE, "agent");
            asm volatile("s_waitcnt vmcnt(0)" ::: "memory");
            const unsigned og = xb_add(&bar[XB_TOP], 1u);
            const unsigned tg = og / nx;
            if (og + 1u == (tg + 1u) * nx) xb_add(&bar[XB_TOPGEN], 1u);
            else XB_SPIN(xb_ld(&bar[XB_TOPGEN]) == tg, bar);
            __builtin_amdgcn_fence(__ATOMIC_ACQUIRE, "agent");
            xb_add(&bar[XB_XGEN(b.x)], 1u);
            asm volatile("s_waitcnt vmcnt(0)" ::: "memory");
        } else {
            XB_SPIN(xb_ld(&bar[XB_XGEN(b.x)]) == gen, bar);
            __builtin_amdgcn_fence(__ATOMIC_ACQUIRE, "agent");
            asm volatile("s_waitcnt vmcnt(0)" ::: "memory");
        }
    }
    __syncthreads();
}

struct Args {
    const float* in[32]; float* out; unsigned char* ws; int ph_lo, ph_hi;
};
struct Frame {
    LAS unsigned char* lds; int tid, lane, wave, G, bid;
    const float* const* in;
    float* out; unsigned char* ws;
    float* H;
    bf16_t* XB;
    bf16_t* XB2;
    bf16_t* HID;
    bf16_t* Z;
    bf16_t* GT;
    float* SSQ; float* GLR; float* ABAR; float* BBAR;
};
enum { I_XP = 0, I_XS, I_SGLA, I_S5RE, I_S5IM, I_META, I_NFFN1, I_F1G, I_F1U, I_F1D, I_NMIX, I_WIN, I_GUP, I_GB, I_GNORM, I_GWO, I_ARE, I_AIM, I_LOGDT, I_BRE, I_BIM, I_CRE, I_CIM, I_S5D,
       I_GLUA, I_GLUB, I_WOUT, I_NFFN2, I_F2G, I_F2U, I_F2D, I_NFINAL };

__device__ __forceinline__ void conv_block(const float* W, int ldw, int c0, int nvalid, const float* gain, bf16_t* dst, int K, int n0, int k0, LAS float* scr, int lane) {
    const int cl = lane & 31;
#pragma unroll 8
    for (int i = 0; i < 32; ++i) { const int kk = 2 * i + (lane >> 5); float v = 0.f;
        if (cl < nvalid) { v = W[(size_t)(k0 + kk) * ldw + c0 + cl]; if (gain) v *= gain[k0 + kk]; }
        scr[kk * 33 + cl] = v; }
    LDS_WAIT(); asm volatile("" ::: "memory");
    const int c = lane & 7;
#pragma unroll
    for (int j = 0; j < 4; ++j) { const int n = (lane >> 3) + 8 * j; const LAS float* s = scr + (8 * c) * 33 + n;
        u32x4 o; o.x = pk2(s[0 * 33], s[1 * 33]); o.y = pk2(s[2 * 33], s[3 * 33]); o.z = pk2(s[4 * 33], s[5 * 33]); o.w = pk2(s[6 * 33], s[7 * 33]);
        *(u32x4*)(dst + (size_t)(n0 + n) * K + k0 + 8 * c) = o; }
    LDS_WAIT(); asm volatile("" ::: "memory");
}
__device__ __forceinline__ double dexp(double x) {
    const double n = __builtin_rint(x * 1.4426950408889634); const double f = x - n * 0.6931471805599453094;
    double t = 1.0, s = 1.0;
#pragma unroll
    for (int i = 1; i <= 16; ++i) { t = t * f / (double)i; s += t; }
    const long long bits = (long long)(1023 + (int)n) << 52; return s * __builtin_bit_cast(double, bits);
}
__device__ __forceinline__ void dsincos(double x, double& sn, double& cs) {
    const double k = __builtin_rint(x * 0.6366197723675814); const double r = (x - k * 1.5707963267948966) - k * 6.123233995736766e-17;
    const double r2 = r * r; double ts = r, ss = r, tc = 1.0, sc = 1.0;
#pragma unroll
    for (int i = 1; i <= 9; ++i) { ts = -ts * r2 / (double)((2 * i) * (2 * i + 1)); ss += ts; tc = -tc * r2 / (double)((2 * i - 1) * (2 * i)); sc += tc; }
    const int q = ((int)k) & 3;
    sn = (q == 0) ? ss : (q == 1) ? sc : (q == 2) ? -ss : -sc;
    cs = (q == 0) ? sc : (q == 1) ? -ss : (q == 2) ? -sc : ss;
}
__device__ __forceinline__ void p0_prologue(Frame& F) {
    LAS float* scr = (LAS float*)(F.lds + F.wave * 16384);
    const int gw = F.bid * 8 + F.wave, NGW = F.G * 8;
    const float* const* in = F.in;
    bf16_t* WT1 = (bf16_t*)(F.ws + WS_WT1); bf16_t* WD1 = (bf16_t*)(F.ws + WS_WD1); bf16_t* WIN = (bf16_t*)(F.ws + WS_WIN); bf16_t* WGO = (bf16_t*)(F.ws + WS_WGO);
    bf16_t* WGLU = (bf16_t*)(F.ws + WS_WGLU); bf16_t* WO = (bf16_t*)(F.ws + WS_WO); bf16_t* WT2 = (bf16_t*)(F.ws + WS_WT2); bf16_t* WD2 = (bf16_t*)(F.ws + WS_WD2);
    constexpr int I_GU = 16 * 176, I_DN = 44 * 32, I_IN = 16 * 200, I_SQ = 16 * 32, I_GL = 16 * 64;
    constexpr int NITEMS = 2 * I_GU + 2 * I_DN + I_IN + 2 * I_SQ + I_GL;
    for (int it = gw; it < NITEMS; it += NGW) {
        int r = it;
        if (r < 2 * I_GU) {
            const int second = r >= I_GU; if (second) r -= I_GU;
            const int nb = r % 176, kb = r / 176, n0 = 32 * nb, t = n0 >> 8, bj = (n0 >> 7) & 1, j = n0 & 127;
            const float* W = in[second ? (bj ? I_F2U : I_F2G) : (bj ? I_F1U : I_F1G)];
            conv_block(W, FF, 128 * t + j, 32, in[second ? I_NFFN2 : I_NFFN1], second ? WT2 : WT1, D, n0, 64 * kb, scr, F.lane); continue; }
        r -= 2 * I_GU;
        if (r < 2 * I_DN) { const int second = r >= I_DN; if (second) r -= I_DN; const int nb = r % 32, kb = r / 32;
            conv_block(in[second ? I_F2D : I_F1D], D, 32 * nb, 32, nullptr, second ? WD2 : WD1, FF, 32 * nb, 64 * kb, scr, F.lane); continue; }
        r -= 2 * I_DN;
        if (r < I_IN) { const int nb = r % 200, kb = r / 200, n0 = 32 * nb; int c0, nv;
            if (n0 < 3072) { c0 = n0; nv = 32; } else if (n0 < 6144) { c0 = n0 + 16; nv = 32; } else if (n0 == 6144) { c0 = 3072; nv = 16; } else { c0 = 0; nv = 0; }
            conv_block(in[I_WIN], 6160, c0, nv, in[I_NMIX], WIN, D, n0, 64 * kb, scr, F.lane); continue; }
        r -= I_IN;
        if (r < I_SQ) { const int nb = r % 32, kb = r / 32; conv_block(in[I_GWO], D, 32 * nb, 32, in[I_GNORM], WGO, D, 32 * nb, 64 * kb, scr, F.lane); continue; }
        r -= I_SQ;
        if (r < I_SQ) { const int nb = r % 32, kb = r / 32; conv_block(in[I_WOUT], D, 32 * nb, 32, nullptr, WO, D, 32 * nb, 64 * kb, scr, F.lane); continue; }
        r -= I_SQ;
        { const int nb = r % 64, kb = r / 64, n0 = 32 * nb, t = n0 >> 8, bj = (n0 >> 7) & 1, j = n0 & 127;
          conv_block(in[bj ? I_GLUB : I_GLUA], D, 128 * t + j, 32, nullptr, WGLU, D, n0, 64 * kb, scr, F.lane); }
    }
    for (int m = gw; m < R_PAD; m += NGW) {
        const float* xr = m < R_PROMPT ? in[I_XP] + (size_t)m * D : m < R_TOK ? in[I_XS] + (size_t)(m - R_PROMPT) * D : m < R_ALL ? in[I_META] + (size_t)(m - R_TOK) * D : nullptr;
        f32x4 v[4]; float s = 0.f;
#pragma unroll
        for (int j = 0; j < 4; ++j) { v[j] = xr ? ((const f32x4*)xr)[F.lane + 64 * j] : (f32x4){0.f, 0.f, 0.f, 0.f}; s += (v[j].x * v[j].x + v[j].y * v[j].y) + (v[j].z * v[j].z + v[j].w * v[j].w); }
        s = wave_sum(s);
        u32x2* o8 = (u32x2*)(F.XB + (size_t)m * D) + F.lane;
#pragma unroll
        for (int j = 0; j < 4; ++j) { u32x2 w; w.x = pk2(v[j].x, v[j].y); w.y = pk2(v[j].z, v[j].w); o8[64 * j] = w; }
        if (F.lane < 16) F.SSQ[(size_t)m * 16 + F.lane] = F.lane == 0 ? s : 0.f;
    }
    for (int i = F.bid * 512 + F.tid; i < S5G * S5P; i += F.G * 512) {
        const int g = i >> 6;
        const double lre = (double)in[I_ARE][i], lim = (double)in[I_AIM][i], dt = dexp((double)in[I_LOGDT][g]);
        double sn, cs; dsincos(lim * dt, sn, cs); const double mag = dexp(lre * dt);
        const double are = mag * cs, aim = mag * sn;
        F.ABAR[2 * i] = (float)are; F.ABAR[2 * i + 1] = (float)aim;
        const double nr = are - 1.0, ni = aim, den = lre * lre + lim * lim;
        const double cr = (nr * lre + ni * lim) / den, cim = (ni * lre - nr * lim) / den;
        for (int c = 0; c < S5C; ++c) { const double br = (double)in[I_BRE][(size_t)i * S5C + c], bi = (double)in[I_BIM][(size_t)i * S5C + c];
            F.BBAR[(size_t)i * 32 + c] = (float)(cr * br - cim * bi); F.BBAR[(size_t)i * 32 + 16 + c] = (float)(cr * bi + cim * br); }
    }
}

__device__ __forceinline__ void p10_final(Frame& F) {
    const int gw = F.bid * 8 + F.wave, NGW = F.G * 8;
    const f32x4* gp = (const f32x4*)F.in[I_NFINAL];
    for (int m = gw; m < R_TOK; m += NGW) {
        const float rs = pg8::row_rstd(F.SSQ, m);
        f32x4* xr = (f32x4*)(F.H + (size_t)m * D);
#pragma unroll
        for (int j = 0; j < 4; ++j) { const f32x4 v = xr[F.lane + 64 * j]; xr[F.lane + 64 * j] = v * rs * gp[F.lane + 64 * j]; }
    }
}

#define MFMA32(a, b, c) __builtin_amdgcn_mfma_f32_32x32x16_bf16((a), (b), (c), 0, 0, 0)
#define MFMA16(a, b, c) __builtin_amdgcn_mfma_f32_16x16x32_bf16((a), (b), (c), 0, 0, 0)
__device__ __forceinline__ float log_sigmoid(float x) { return fminf(x, 0.f) - __logf(1.0f + __expf(-fabsf(x))); }
__device__ __forceinline__ int crow(int r, int hh) { return (r & 3) + 8 * (r >> 2) + 4 * hh; }

constexpr int GL_GLR = 0, GL_TOT = 4096, GL_DEC = 6144, GL_QE = 8192, GL_KE = 25600, GL_KDT = 43008, GL_VT = 61440, GL_P = 98304, GL_OT = 107520, GL_END = 141312;
constexpr int QROW = 272, SROW = 144, OROW = 528;
static_assert(GL_END <= MISC_OFF, "GLA LDS map");
__device__ __forceinline__ void gla_prompt_unit(Frame& F, int b, int h) {
    LAS unsigned char* lds = F.lds;
    const int tid = F.tid, lane = F.lane, w = F.wave, l31 = lane & 31, hh = lane >> 5;
    const int d = tid & 127, tq = __builtin_amdgcn_readfirstlane(tid >> 7);
    const float* Wup = F.in[I_GUP]; const float* bgate = F.in[I_GB];
    float wup[16];
#pragma unroll
    for (int j = 0; j < 16; ++j) wup[j] = Wup[j * 512 + h * 128 + d];
    const float bg = bgate[h * 128 + d];
    f32x16 S[4];
#pragma unroll
    for (int i = 0; i < 4; ++i)
#pragma unroll
        for (int r = 0; r < 16; ++r) S[i][r] = 0.f;
    for (int ci = 0; ci <= 32; ++ci) {
        const int row0 = ci == 0 ? R_META : b * SEQ + (ci - 1) * 64, nvalid = ci == 0 ? NMETA : 64;
        { const int t = tid >> 3, j2 = (tid & 7) * 2; f32x2 v = (f32x2){0.f, 0.f}; if (t < nvalid) v = *(const f32x2*)(F.GLR + (size_t)(row0 + t) * 16 + j2);
          *(LAS f32x2*)(lds + GL_GLR + (t * 16 + j2) * 4) = v; }
        unsigned qk[16];
#pragma unroll
        for (int i = 0; i < 16; ++i) { const int t = 16 * tq + i; const bool ok = t < nvalid; const bf16_t* zr = F.Z + (size_t)(row0 + (ok ? t : 0)) * ZC + h * 128 + d;
            const unsigned v = (unsigned)zr[ZQ] | ((unsigned)zr[ZK] << 16); qk[i] = ok ? v : 0u; }
        u32x4 rr[4];
        { const int t = tid >> 3; const bool ok = (ci > 0); const u32x4* rp = (const u32x4*)(F.Z + (size_t)(row0 + (ok ? t : 0)) * ZC + ZR + h * 256 + 32 * (tid & 7));
#pragma unroll
          for (int i = 0; i < 4; ++i) rr[i] = rp[i]; }
        {
          const int e = tid & 255, sh = __builtin_amdgcn_readfirstlane(tid >> 8);
#pragma unroll
          for (int c4 = 0; c4 < 4; ++c4) { unsigned pw[4];
#pragma unroll
              for (int i2 = 0; i2 < 4; ++i2) { const int s0 = 32 * sh + 8 * c4 + 2 * i2; const bool ok0 = s0 < nvalid, ok1 = s0 + 1 < nvalid;
                  const bf16_t* vp = F.Z + ZV + h * 256 + e;
                  const unsigned v0 = vp[(size_t)(row0 + (ok0 ? s0 : 0)) * ZC], v1 = vp[(size_t)(row0 + (ok1 ? s0 + 1 : 0)) * ZC];
                  pw[i2] = (ok0 ? v0 : 0u) | ((ok1 ? v1 : 0u) << 16); }
              *(LAS u32x4*)(lds + GL_VT + e * SROW + (32 * sh + 8 * c4) * 2) = (u32x4){pw[0], pw[1], pw[2], pw[3]}; } }
        __syncthreads();
        float bl[16]; float run = 0.f;
#pragma unroll
        for (int i = 0; i < 16; ++i) { const int t = 16 * tq + i; float x = bg;
#pragma unroll
            for (int j4 = 0; j4 < 4; ++j4) { const f32x4 gv = *(const LAS f32x4*)(lds + GL_GLR + (t * 16 + 4 * j4) * 4);
                x += gv[0] * wup[4 * j4] + gv[1] * wup[4 * j4 + 1] + gv[2] * wup[4 * j4 + 2] + gv[3] * wup[4 * j4 + 3]; }
            const float gval = t < nvalid ? log_sigmoid(x) * (1.0f / 16.0f) : 0.f; run += gval; bl[i] = run; }
        *(LAS float*)(lds + GL_TOT + (tq * 128 + d) * 4) = run;
        __syncthreads();
        float offs = 0.f, blast = 0.f;
#pragma unroll
        for (int q = 0; q < 4; ++q) { const float v = *(const LAS float*)(lds + GL_TOT + (q * 128 + d) * 4); blast += v; if (q < tq) offs += v; }
        { unsigned kd[8];
#pragma unroll
          for (int i = 0; i < 16; i += 2) { float kdv[2];
#pragma unroll
              for (int u2 = 0; u2 < 2; ++u2) { const int t = 16 * tq + i + u2; const float bt = offs + bl[i + u2]; const float q = bflo(qk[i + u2]), k = bfhi(qk[i + u2]);
                  const float qe = q * __expf(bt), ke = k * __expf(-bt); kdv[u2] = k * __expf(blast - bt);
                  *(LAS unsigned short*)(lds + GL_QE + t * QROW + d * 2) = (unsigned short)f2bf(qe);
                  *(LAS unsigned short*)(lds + GL_KE + t * QROW + d * 2) = (unsigned short)f2bf(ke); }
              kd[i >> 1] = pk2(kdv[0], kdv[1]); }
          *(LAS u32x4*)(lds + GL_KDT + d * SROW + (16 * tq) * 2) = (u32x4){kd[0], kd[1], kd[2], kd[3]};
          *(LAS u32x4*)(lds + GL_KDT + d * SROW + (16 * tq + 8) * 2) = (u32x4){kd[4], kd[5], kd[6], kd[7]};
          if (tq == 0) *(LAS float*)(lds + GL_DEC + d * 4) = __expf(blast); }
        __syncthreads();
        if (w < 4) { const int tr = w >> 1, sc = w & 1; f32x16 sa;
#pragma unroll
            for (int r = 0; r < 16; ++r) sa[r] = 0.f;
            if (sc <= tr) {
#pragma unroll
                for (int ks = 0; ks < 8; ++ks) { const bf16x8 a = *(const LAS bf16x8*)(lds + GL_QE + (32 * tr + l31) * QROW + (16 * ks + 8 * hh) * 2);
                    const bf16x8 bb = *(const LAS bf16x8*)(lds + GL_KE + (32 * sc + l31) * QROW + (16 * ks + 8 * hh) * 2); sa = MFMA32(a, bb, sa); } }
#pragma unroll
            for (int r = 0; r < 16; ++r) { const int t = 32 * tr + crow(r, hh), s = 32 * sc + l31; const float v = (s <= t) ? sa[r] : 0.f;
                *(LAS unsigned short*)(lds + GL_P + t * SROW + s * 2) = (unsigned short)f2bf(v); } }
        __syncthreads();
        { bf16x8 vt[4];
#pragma unroll
          for (int ks = 0; ks < 4; ++ks) vt[ks] = *(const LAS bf16x8*)(lds + GL_VT + (32 * w + l31) * SROW + (16 * ks + 8 * hh) * 2);
          f32x16 oa[2];
#pragma unroll
          for (int tr = 0; tr < 2; ++tr) {
#pragma unroll
              for (int r = 0; r < 16; ++r) oa[tr][r] = 0.f;
#pragma unroll
              for (int ks = 0; ks < 4; ++ks) { if (tr == 0 && ks >= 2) continue;
                  const bf16x8 a = *(const LAS bf16x8*)(lds + GL_P + (32 * tr + l31) * SROW + (16 * ks + 8 * hh) * 2); oa[tr] = MFMA32(a, vt[ks], oa[tr]); } }
#pragma unroll
          for (int dr = 0; dr < 4; ++dr)
#pragma unroll
              for (int s2 = 0; s2 < 2; ++s2) { u32x4 bw; bw.x = pk2(S[dr][8 * s2 + 0], S[dr][8 * s2 + 1]); bw.y = pk2(S[dr][8 * s2 + 2], S[dr][8 * s2 + 3]);
                  bw.z = pk2(S[dr][8 * s2 + 4], S[dr][8 * s2 + 5]); bw.w = pk2(S[dr][8 * s2 + 6], S[dr][8 * s2 + 7]); const bf16x8 bfrag = __builtin_bit_cast(bf16x8, bw);
#pragma unroll
                  for (int tr = 0; tr < 2; ++tr) { const int dcol = 32 * dr + 16 * s2 + 4 * hh;
                      const u32x2 a0 = *(const LAS u32x2*)(lds + GL_QE + (32 * tr + l31) * QROW + dcol * 2), a1 = *(const LAS u32x2*)(lds + GL_QE + (32 * tr + l31) * QROW + (dcol + 8) * 2);
                      const bf16x8 a = __builtin_bit_cast(bf16x8, (u32x4){a0.x, a0.y, a1.x, a1.y}); oa[tr] = MFMA32(a, bfrag, oa[tr]); } }
#pragma unroll
          for (int dr = 0; dr < 4; ++dr) {
#pragma unroll
              for (int g4 = 0; g4 < 4; ++g4) { const f32x4 dc = *(const LAS f32x4*)(lds + GL_DEC + (32 * dr + 8 * g4 + 4 * hh) * 4);
#pragma unroll
                  for (int q = 0; q < 4; ++q) S[dr][4 * g4 + q] *= dc[q]; }
#pragma unroll
              for (int ks = 0; ks < 4; ++ks) { const bf16x8 a = *(const LAS bf16x8*)(lds + GL_KDT + (32 * dr + l31) * SROW + (16 * ks + 8 * hh) * 2); S[dr] = MFMA32(a, vt[ks], S[dr]); } }
          if (ci > 0) {
#pragma unroll
              for (int tr = 0; tr < 2; ++tr)
#pragma unroll
                  for (int r = 0; r < 16; ++r) *(LAS unsigned short*)(lds + GL_OT + (32 * tr + crow(r, hh)) * OROW + (32 * w + l31) * 2) = (unsigned short)f2bf(oa[tr][r]); } }
        __syncthreads();
        if (ci > 0) { const int t = tid >> 3, j8 = tid & 7; float ov[32]; float ss = 0.f;
#pragma unroll
            for (int i = 0; i < 4; ++i) { const u32x4 ow = *(const LAS u32x4*)(lds + GL_OT + t * OROW + (32 * j8 + 8 * i) * 2); const unsigned* op = (const unsigned*)&ow;
#pragma unroll
                for (int q = 0; q < 4; ++q) { const float a = bflo(op[q]), c = bfhi(op[q]); ov[8 * i + 2 * q] = a; ov[8 * i + 2 * q + 1] = c; ss += a * a + c * c; } }
            ss += __shfl_xor(ss, 1); ss += __shfl_xor(ss, 2); ss += __shfl_xor(ss, 4);
            const float rs = __builtin_amdgcn_rsqf(ss * (1.0f / 256.0f) + EPS);
            u32x4* op = (u32x4*)(F.Z + (size_t)(row0 + t) * ZC + ZR + h * 256 + 32 * j8);
#pragma unroll
            for (int i = 0; i < 4; ++i) { const unsigned* rp = (const unsigned*)&rr[i]; u32x4 ww; unsigned* wp = (unsigned*)&ww;
#pragma unroll
                for (int q = 0; q < 4; ++q) wp[q] = pk2(ov[8 * i + 2 * q] * rs * bflo(rp[q]), ov[8 * i + 2 * q + 1] * rs * bfhi(rp[q]));
                op[i] = ww; } }
    }
    float* gs = F.out + O_GLAP + ((size_t)(b * NH + h) * DK) * DV;
#pragma unroll
    for (int dr = 0; dr < 4; ++dr)
#pragma unroll
        for (int r = 0; r < 16; ++r) gs[(size_t)(32 * dr + crow(r, hh)) * DV + 32 * w + l31] = S[dr][r];
    __syncthreads();
}

constexpr int S5_HROW = 272, S5_HGRP = 32 * S5_HROW, S5_HBUF = 4 * S5_HGRP;
static_assert(2 * S5_HBUF <= MISC_OFF, "S5 LDS map");
__device__ __forceinline__ bf16x8 split_hi(const float (&x)[8], float (&rem)[8]) {
    unsigned w[4];
#pragma unroll
    for (int i = 0; i < 4; ++i) { const unsigned a = f2bf(x[2 * i]), c = f2bf(x[2 * i + 1]); rem[2 * i] = x[2 * i] - bflo(a); rem[2 * i + 1] = x[2 * i + 1] - bflo(c); w[i] = a | (c << 16); }
    return __builtin_bit_cast(bf16x8, (u32x4){w[0], w[1], w[2], w[3]});
}
__device__ __forceinline__ bf16x8 pack8(const float (&x)[8]) { return __builtin_bit_cast(bf16x8, (u32x4){pk2(x[0], x[1]), pk2(x[2], x[3]), pk2(x[4], x[5]), pk2(x[6], x[7])}); }
__device__ __forceinline__ void s5_prompt_unit(Frame& F, int b, int gq) {
    LAS unsigned char* lds = F.lds;
    const int lane = F.lane, w = F.wave, gi = w >> 1, pc = w & 1, g = 4 * gq + gi, l31 = lane & 31, hh = lane >> 5, p = 32 * pc + l31;
    const float are = F.ABAR[2 * (g * 64 + p)], aim = F.ABAR[2 * (g * 64 + p) + 1];
    bf16x8 brh, brl, bih, bil;
    { float x[8], rem[8];
#pragma unroll
      for (int j = 0; j < 8; ++j) x[j] = F.BBAR[(size_t)(g * 64 + p) * 32 + 8 * hh + j];
      brh = split_hi(x, rem); brl = pack8(rem);
#pragma unroll
      for (int j = 0; j < 8; ++j) x[j] = F.BBAR[(size_t)(g * 64 + p) * 32 + 16 + 8 * hh + j];
      bih = split_hi(x, rem); bil = pack8(rem); }
    bf16x8 cfr[4];
    { const int c = lane & 15, kq = lane >> 4;
#pragma unroll
      for (int ks = 0; ks < 4; ++ks) { float x[8]; const int p0 = 32 * ks + 8 * kq;
#pragma unroll
          for (int j = 0; j < 8; ++j) { const int pp = p0 + j; x[j] = pp < 64 ? F.in[I_CRE][(size_t)(g * 16 + c) * 64 + pp] : -F.in[I_CIM][(size_t)(g * 16 + c) * 64 + (pp - 64)]; }
          cfr[ks] = pack8(x); } }
    const float dco = F.in[I_S5D][g * 16 + (lane & 15)];
    float car = 0.f, cai = 0.f;
    for (int ci = 0; ci <= 64; ++ci) {
        const int row0 = ci == 0 ? R_META : b * SEQ + (ci - 1) * 32, nvalid = ci == 0 ? NMETA : 32;
        bf16x8 a = (bf16x8){0, 0, 0, 0, 0, 0, 0, 0};
        if (l31 < nvalid) a = *(const bf16x8*)(F.Z + (size_t)(row0 + l31) * ZC + ZU + 16 * g + 8 * hh);
        f32x16 hr, hi;
#pragma unroll
        for (int r = 0; r < 16; ++r) { hr[r] = 0.f; hi[r] = 0.f; }
        hr = MFMA32(a, brh, hr); hr = MFMA32(a, brl, hr); hi = MFMA32(a, bih, hi); hi = MFMA32(a, bil, hi);
#pragma unroll
        for (int j = 0; j < 4; ++j) { if (8 * j < nvalid) {
#pragma unroll
            for (int ph = 0; ph < 2; ++ph) { float cr = car, cim = cai;
#pragma unroll
                for (int q = 0; q < 4; ++q) { const int r = 4 * j + q; const float nr = are * cr - aim * cim + hr[r], ni = are * cim + aim * cr + hi[r];
                    hr[r] = (hh == ph) ? nr : hr[r]; hi[r] = (hh == ph) ? ni : hi[r]; cr = nr; cim = ni; }
                car = __shfl_xor(cr, 32); cai = __shfl_xor(cim, 32); } } }
        LAS unsigned char* hb = lds + (ci & 1) * S5_HBUF + gi * S5_HGRP;
#pragma unroll
        for (int r = 0; r < 16; ++r) { const int t = crow(r, hh);
            *(LAS unsigned short*)(hb + t * S5_HROW + p * 2) = (unsigned short)f2bf(hr[r]); *(LAS unsigned short*)(hb + t * S5_HROW + (64 + p) * 2) = (unsigned short)f2bf(hi[r]); }
        __syncthreads();
        if (ci > 0) { f32x4 y = (f32x4){0.f, 0.f, 0.f, 0.f}; const int c = lane & 15, kq = lane >> 4;
#pragma unroll
            for (int ks = 0; ks < 4; ++ks) { const bf16x8 af = *(const LAS bf16x8*)(hb + (16 * pc + c) * S5_HROW + (32 * ks + 8 * kq) * 2); y = MFMA16(af, cfr[ks], y); }
#pragma unroll
            for (int i = 0; i < 4; ++i) { bf16_t* zp = F.Z + (size_t)(row0 + 16 * pc + 4 * kq + i) * ZC + ZU + 16 * g + c; const float u = bf2f(*zp); *zp = (bf16_t)f2bf(gelu_tanh(y[i] + dco * u)); } }
    }
    if (hh == 0) { F.out[O_S5RP + (size_t)(b * S5G + g) * S5P + p] = car; F.out[O_S5IP + (size_t)(b * S5G + g) * S5P + p] = cai; }
    __syncthreads();
}

constexpr int GS_QE = 0, GS_KE = 2048, GS_KD = 4096, GS_DEC = 6144, GS_A = 6656, GS_V = 6784, GS_OP = 10880, GS_RED = 43648;
__device__ __forceinline__ void gla_sample_unit(Frame& F, int bs, int h) {
    LAS unsigned char* lds = F.lds; const int tid = F.tid, lane = F.lane, w = F.wave;
    const int row0 = R_PROMPT + bs * DECS;
    LAS float* QE = (LAS float*)(lds + GS_QE); LAS float* KE = (LAS float*)(lds + GS_KE); LAS float* KD = (LAS float*)(lds + GS_KD); LAS float* DEC = (LAS float*)(lds + GS_DEC);
    LAS float* AS = (LAS float*)(lds + GS_A); LAS float* VS = (LAS float*)(lds + GS_V); LAS float* OP = (LAS float*)(lds + GS_OP); LAS float* RED = (LAS float*)(lds + GS_RED);
    if (tid < 128) { const int d = tid; float bsum = 0.f, bt[4], q[4], k[4];
#pragma unroll
        for (int t = 0; t < 4; ++t) { float x = F.in[I_GB][h * 128 + d];
#pragma unroll
            for (int j = 0; j < 16; ++j) x += F.GLR[(size_t)(row0 + t) * 16 + j] * F.in[I_GUP][j * 512 + h * 128 + d];
            bsum += log_sigmoid(x) * (1.0f / 16.0f); bt[t] = bsum;
            q[t] = bf2f(F.Z[(size_t)(row0 + t) * ZC + ZQ + h * 128 + d]); k[t] = bf2f(F.Z[(size_t)(row0 + t) * ZC + ZK + h * 128 + d]); }
#pragma unroll
        for (int t = 0; t < 4; ++t) { QE[t * 128 + d] = q[t] * __expf(bt[t]); KE[t * 128 + d] = k[t] * __expf(-bt[t]); KD[t * 128 + d] = k[t] * __expf(bsum - bt[t]); }
        DEC[d] = __expf(bsum); }
    for (int i = tid; i < 4 * 256; i += 512) VS[i] = bf2f(F.Z[(size_t)(row0 + (i >> 8)) * ZC + ZV + h * 256 + (i & 255)]);
    __syncthreads();
    if (tid < 16) { const int t = tid >> 2, s = tid & 3; float a = 0.f; if (s <= t) { for (int d = 0; d < 128; ++d) a += QE[t * 128 + d] * KE[s * 128 + d]; } AS[tid] = a; }
    const float* s0 = F.in[I_SGLA] + ((size_t)(bs * NH + h) * DK) * DV; float* s1 = F.out + O_GLAS + ((size_t)(bs * NH + h) * DK) * DV;
    f32x4 v4[4], op[4];
#pragma unroll
    for (int t = 0; t < 4; ++t) { v4[t] = *(const LAS f32x4*)(VS + t * 256 + 4 * lane); op[t] = (f32x4){0.f, 0.f, 0.f, 0.f}; }
#pragma unroll 4
    for (int i = 0; i < 16; ++i) { const int d = 16 * w + i; const f32x4 s = *(const f32x4*)(s0 + (size_t)d * DV + 4 * lane); f32x4 sn = s * DEC[d];
#pragma unroll
        for (int t = 0; t < 4; ++t) { op[t] += s * QE[t * 128 + d]; sn += v4[t] * KD[t * 128 + d]; }
        *(f32x4*)(s1 + (size_t)d * DV + 4 * lane) = sn; }
#pragma unroll
    for (int t = 0; t < 4; ++t) *(LAS f32x4*)(OP + (w * 4 + t) * 256 + 4 * lane) = op[t];
    __syncthreads();
    { const int t = tid >> 7, e = 2 * (tid & 127); float o0 = 0.f, o1 = 0.f;
#pragma unroll
      for (int ww = 0; ww < 8; ++ww) { const f32x2 pv = *(const LAS f32x2*)(OP + (ww * 4 + t) * 256 + e); o0 += pv.x; o1 += pv.y; }
#pragma unroll
      for (int s = 0; s < 4; ++s) { const float a = AS[t * 4 + s]; o0 += a * VS[s * 256 + e]; o1 += a * VS[s * 256 + e + 1]; }
      float ss = wave_sum(o0 * o0 + o1 * o1);
      if (lane == 0) RED[w] = ss;
      __syncthreads();
      ss = RED[2 * t] + RED[2 * t + 1];
      const float rs = __builtin_amdgcn_rsqf(ss * (1.0f / 256.0f) + EPS);
      unsigned* zp = (unsigned*)(F.Z + (size_t)(row0 + t) * ZC + ZR + h * 256 + e); const unsigned rw = *zp;
      *zp = pk2(o0 * rs * bflo(rw), o1 * rs * bfhi(rw)); }
    __syncthreads();
}

__device__ __forceinline__ void s5_sample_unit(Frame& F, int bs) {
    LAS unsigned char* lds = F.lds; const int lane = F.lane, w = F.wave; const int row0 = R_PROMPT + bs * DECS;
    LAS float* US = (LAS float*)(lds + w * 4096);
    LAS float* HS = (LAS float*)(lds + w * 4096 + 256);
    for (int gg = 0; gg < 8; ++gg) { const int g = 8 * w + gg, p = lane;
        { const int t = lane >> 4, c = lane & 15; US[lane] = bf2f(F.Z[(size_t)(row0 + t) * ZC + ZU + 16 * g + c]); }
        const float are = F.ABAR[2 * (g * 64 + p)], aim = F.ABAR[2 * (g * 64 + p) + 1];
        float bre[16], bim[16];
#pragma unroll
        for (int c4 = 0; c4 < 4; ++c4) { const f32x4 x = *(const f32x4*)(F.BBAR + (size_t)(g * 64 + p) * 32 + 4 * c4), y = *(const f32x4*)(F.BBAR + (size_t)(g * 64 + p) * 32 + 16 + 4 * c4);
#pragma unroll
            for (int q = 0; q < 4; ++q) { bre[4 * c4 + q] = x[q]; bim[4 * c4 + q] = y[q]; } }
        float hr = F.in[I_S5RE][(size_t)(bs * S5G + g) * S5P + p], hi = F.in[I_S5IM][(size_t)(bs * S5G + g) * S5P + p];
        LDS_WAIT(); asm volatile("" ::: "memory");
#pragma unroll
        for (int t = 0; t < 4; ++t) { float ur = 0.f, ui = 0.f;
#pragma unroll
            for (int c = 0; c < 16; ++c) { const float u = US[t * 16 + c]; ur += bre[c] * u; ui += bim[c] * u; }
            const float nr = are * hr - aim * hi + ur, ni = are * hi + aim * hr + ui; hr = nr; hi = ni; HS[t * 128 + p] = hr; HS[t * 128 + 64 + p] = hi; }
        F.out[O_S5RS + (size_t)(bs * S5G + g) * S5P + p] = hr; F.out[O_S5IS + (size_t)(bs * S5G + g) * S5P + p] = hi;
        LDS_WAIT(); asm volatile("" ::: "memory");
        { const int t = lane >> 4, c = lane & 15; const float* cre = F.in[I_CRE] + (size_t)(g * 16 + c) * 64; const float* cim = F.in[I_CIM] + (size_t)(g * 16 + c) * 64; float y = 0.f;
#pragma unroll 4
          for (int p4 = 0; p4 < 16; ++p4) { const f32x4 a = *(const f32x4*)(cre + 4 * p4), bq = *(const f32x4*)(cim + 4 * p4);
              const f32x4 xr = *(const LAS f32x4*)(HS + t * 128 + 4 * p4), xi = *(const LAS f32x4*)(HS + t * 128 + 64 + 4 * p4);
              y += (a[0] * xr[0] + a[1] * xr[1] + a[2] * xr[2] + a[3] * xr[3]) - (bq[0] * xi[0] + bq[1] * xi[1] + bq[2] * xi[2] + bq[3] * xi[3]); }
          y += F.in[I_S5D][g * 16 + c] * US[lane];
          F.Z[(size_t)(row0 + t) * ZC + ZU + 16 * g + c] = (bf16_t)f2bf(gelu_tanh(y)); }
        LDS_WAIT(); asm volatile("" ::: "memory");
    }
}

__device__ __forceinline__ void p4_mixers(Frame& F) {
    const int bid = F.bid, G = F.G;
#ifndef P4M
#define P4M 15
#endif
    if (bid < 32) { if (P4M & 1) gla_prompt_unit(F, bid >> 2, bid & 3); }
    else if (bid < 160) { if (P4M & 2) s5_prompt_unit(F, (bid - 32) >> 4, (bid - 32) & 15); }
    else { const int nb = G - 160;
        for (int u = bid - 160; u < 640; u += nb) { if (u < 512) { if (P4M & 4) gla_sample_unit(F, u >> 2, u & 3); } else { if (P4M & 8) s5_sample_unit(F, u - 512); } } }
}

constexpr int N_PHASES = 11;
__global__ void __launch_bounds__(512, 2) mk_fwd(Args args) {
    extern __shared__ __attribute__((aligned(16))) unsigned char lds_raw[];
    Frame F;
    F.lds = (LAS unsigned char*)lds_raw;
    F.tid = threadIdx.x; F.lane = F.tid & 63; F.wave = __builtin_amdgcn_readfirstlane(F.tid >> 6); F.G = gridDim.x; F.bid = blockIdx.x;
    F.in = args.in; F.out = args.out; F.ws = args.ws;
    F.H = args.out; F.XB = (bf16_t*)(args.out + O_GLAS); F.XB2 = (bf16_t*)(args.ws + WS_REGB); F.HID = (bf16_t*)(args.ws + WS_REGA); F.Z = (bf16_t*)(args.ws + WS_REGA); F.GT = (bf16_t*)(args.ws + WS_REGB);
    F.SSQ = (float*)(args.ws + WS_SSQ); F.GLR = (float*)(args.ws + WS_GLR); F.ABAR = (float*)(args.ws + WS_ABAR); F.BBAR = (float*)(args.ws + WS_BBAR);
    volatile LAS unsigned* MISC = (volatile LAS unsigned*)(F.lds + MISC_OFF);
    for (int u = F.tid; u < (LDS_BYTES - MISC_OFF) / 4; u += 512) MISC[u] = 0u;
    __syncthreads();
    XcdBarrier bar; bar.bar = (unsigned*)(args.ws + WS_CTL) + CW_BAR; bar.x = 0; bar.st = nullptr;
    const int lo = args.ph_lo, hi = args.ph_hi;
    if (hi - lo > 1) bar = xcd_barrier_post((unsigned*)(args.ws + WS_CTL) + CW_BAR, MISC + 8);
#ifndef PHM
#define PHM 0x7ff
#endif
#define IN(k) (((PHM >> (k)) & 1) && lo <= (k) && (k) < hi)
#define SEAM(k) do { if (IN(k) && IN((k) + 1)) xcd_barrier(bar); } while (0)
    const bf16_t* WT1 = (const bf16_t*)(args.ws + WS_WT1); const bf16_t* WD1 = (const bf16_t*)(args.ws + WS_WD1); const bf16_t* WIN = (const bf16_t*)(args.ws + WS_WIN); const bf16_t* WGO = (const bf16_t*)(args.ws + WS_WGO);
    const bf16_t* WGLU = (const bf16_t*)(args.ws + WS_WGLU); const bf16_t* WO = (const bf16_t*)(args.ws + WS_WO); const bf16_t* WT2 = (const bf16_t*)(args.ws + WS_WT2); const bf16_t* WD2 = (const bf16_t*)(args.ws + WS_WD2);

    if (IN(0)) { p0_prologue(F); } SEAM(0);
    if (IN(1)) {
        pg8::Gemm g{F.XB, WT1, R_PAD, 5632, D, D}; pg8::StaticOrder S; S.init(R_PAD, 5632, F.G, F.bid);
        pg8::EpiGU E{F.HID, FF, F.SSQ}; pg8::gemm_phase(F.lds, g, S, E); } SEAM(1);
    if (IN(2)) {
        pg8::Gemm g{F.HID, WD1, R_PAD, D, FF, FF}; pg8::StaticOrder S; S.init(R_PAD, D, F.G, F.bid);
        pg8::EpiRes E{0, F.in[I_XP], F.in[I_XS], F.in[I_META], F.H, F.XB, F.SSQ, 0.5f}; pg8::gemm_phase(F.lds, g, S, E); } SEAM(2);
    if (IN(3)) {
        pg8::Gemm g{F.XB, WIN, R_PAD, NWIN, D, D}; pg8::StaticOrder S; S.init(R_PAD, NWIN, F.G, F.bid);
        pg8::EpiZ E{F.Z, F.GT, F.GLR, F.SSQ}; pg8::gemm_phase(F.lds, g, S, E); } SEAM(3);
    if (IN(4)) { p4_mixers(F); } SEAM(4);
    if (IN(5)) {
        pg8::Gemm g{F.Z + ZU, WGLU, R_TOK, 2048, D, ZC}; pg8::StaticOrder S; S.init(R_TOK, 2048, F.G, F.bid);
        pg8::EpiGLU E{F.GT, F.Z}; pg8::gemm_phase(F.lds, g, S, E); } SEAM(5);
    if (IN(6)) {
        pg8::Gemm g{F.Z + ZR, WGO, R_TOK, D, D, ZC}; pg8::StaticOrder S; S.init(R_TOK, D, F.G, F.bid);
        pg8::EpiGO E{F.GT, F.Z, F.Z + 1024}; pg8::gemm_phase(F.lds, g, S, E); } SEAM(6);
    if (IN(7)) {
        pg8::Gemm g{F.Z + 1024, WO, R_TOK, D, D, ZC}; pg8::StaticOrder S; S.init(R_TOK, D, F.G, F.bid);
        pg8::EpiRes E{1, nullptr, nullptr, nullptr, F.H, F.XB2, F.SSQ, 1.0f}; pg8::gemm_phase(F.lds, g, S, E); } SEAM(7);
    if (IN(8)) {
        pg8::Gemm g{F.XB2, WT2, R_TOK, 5632, D, D}; pg8::StaticOrder S; S.init(R_TOK, 5632, F.G, F.bid);
        pg8::EpiGU E{F.HID, FF, F.SSQ}; pg8::gemm_phase(F.lds, g, S, E); } SEAM(8);
    if (IN(9)) {
        pg8::Gemm g{F.HID, WD2, R_TOK, D, FF, FF}; pg8::StaticOrder S; S.init(R_TOK, D, F.G, F.bid);
        pg8::EpiRes E{1, nullptr, nullptr, nullptr, F.H, nullptr, F.SSQ, 0.5f}; pg8::gemm_phase(F.lds, g, S, E); } SEAM(9);
    if (IN(10)) { p10_final(F); }
#undef IN
#undef SEAM
}

extern "C" void kernel_launch(void* const* d_in, const int* in_sizes, int n_in, void* d_out, int out_size, void* d_ws, size_t ws_size, hipStream_t stream) {
    static int grid = 0;
    if (grid == 0) {
        if (n_in != 32 || (size_t)out_size != O_END || ws_size < WS_END) { fprintf(stderr, "kernel_launch: unexpected shapes: n_in %d out %d ws %zu (need %zu)\n", n_in, out_size, ws_size, (size_t)WS_END); grid = -1; return; }
        int dev = 0, cus = 0, per_cu = 0;
        if (hipGetDevice(&dev) != hipSuccess || hipDeviceGetAttribute(&cus, hipDeviceAttributeMultiprocessorCount, dev) != hipSuccess) { grid = -1; return; }
        if (hipFuncSetAttribute((const void*)mk_fwd, hipFuncAttributeMaxDynamicSharedMemorySize, LDS_BYTES) != hipSuccess) { fprintf(stderr, "kernel_launch: hipFuncSetAttribute failed\n"); grid = -1; return; }
        if (hipOccupancyMaxActiveBlocksPerMultiprocessor(&per_cu, (const void*)mk_fwd, 512, LDS_BYTES) != hipSuccess || per_cu < 1) { fprintf(stderr, "kernel_launch: occupancy query says %d\n", per_cu); per_cu = 1; }
        (void)hipGetLastError();
        grid = cus;
    }
    if (grid < 0) return;
    (void)hipMemsetAsync((char*)d_ws + WS_CTL, 0, CTL_ZERO_BYTES, stream);
    Args a{};
    for (int i = 0; i < 32; ++i) a.in[i] = (const float*)d_in[i];
    a.out = (float*)d_out; a.ws = (unsigned char*)d_ws;
#if MK_PER_PHASE
    for (int p = 0; p < N_PHASES; ++p) { a.ph_lo = p; a.ph_hi = p + 1; hipLaunchKernelGGL(mk_fwd, dim3(grid), dim3(512), LDS_BYTES, stream, a); }
#else
    a.ph_lo = 0; a.ph_hi = N_PHASES;
    void* kargs[] = {&a};
    hipError_t e = hipLaunchCooperativeKernel((const void*)mk_fwd, dim3(grid), dim3(512), kargs, LDS_BYTES, stream);
    if (e != hipSuccess) fprintf(stderr, "kernel_launch: cooperative launch failed: %s (grid %d)\n", hipGetErrorString(e), grid);
#endif
}
```

```cpp
#include <hip/hip_runtime.h>
#include <cstdio>
#include <cstdint>

#define LAS __attribute__((address_space(3)))
#define GAS __attribute__((address_space(1)))
typedef unsigned short bf16_t;
typedef short bf16x8 __attribute__((ext_vector_type(8)));
typedef float f32x2 __attribute__((ext_vector_type(2)));
typedef float f32x4 __attribute__((ext_vector_type(4)));
typedef float f32x16 __attribute__((ext_vector_type(16)));
typedef unsigned u32x2 __attribute__((ext_vector_type(2)));
typedef unsigned u32x4 __attribute__((ext_vector_type(4)));
typedef GAS unsigned gu32;

#ifndef MK_PER_PHASE
#define MK_PER_PHASE 0
#endif

constexpr int D = 1024, FF = 2816, NBATCH = 8, SEQ = 2048, DECB = 128, DECS = 4, NMETA = 16;
constexpr int NH = 4, DK = 128, DV = 256, GRANK = 16, S5G = 64, S5C = 16, S5P = 64;
constexpr int R_PROMPT = NBATCH * SEQ;
constexpr int R_SAMPLE = DECB * DECS;
constexpr int R_TOK = R_PROMPT + R_SAMPLE;
constexpr int R_META = R_TOK;
constexpr int R_ALL = R_TOK + NMETA;
constexpr int R_PAD = 17152;
constexpr int ZC = 4096, ZQ = 0, ZK = 512, ZV = 1024, ZR = 2048, ZU = 3072;
constexpr int NWIN = 6400;
constexpr float EPS = 1e-6f;
constexpr size_t O_YP = 0, O_YS = 16777216, O_GLAP = 17301504, O_S5RP = 18350080, O_S5IP = 18382848, O_GLAS = 18415616, O_S5RS = 35192832, O_S5IS = 35717120, O_END = 36241408;
constexpr size_t WS_CTL = 0, CTL_ZERO_BYTES = 65536;
constexpr size_t WS_SSQ = 65536;
constexpr size_t WS_GLR = WS_SSQ + (size_t)R_PAD * 16 * 4;
constexpr size_t WS_ABAR = WS_GLR + (size_t)R_ALL * 16 * 4;
constexpr size_t WS_BBAR = WS_ABAR + 64 * 64 * 2 * 4;
constexpr size_t WS_W = 2883584;
constexpr size_t WS_WT1 = WS_W, WS_WD1 = WS_WT1 + (size_t)5632 * 1024 * 2, WS_WIN = WS_WD1 + (size_t)1024 * 2816 * 2, WS_WGO = WS_WIN + (size_t)NWIN * 1024 * 2,
                 WS_WGLU = WS_WGO + (size_t)1024 * 1024 * 2, WS_WO = WS_WGLU + (size_t)2048 * 1024 * 2, WS_WT2 = WS_WO + (size_t)1024 * 1024 * 2, WS_WD2 = WS_WT2 + (size_t)5632 * 1024 * 2;
constexpr size_t WS_REGA = WS_WD2 + (size_t)1024 * 2816 * 2;
constexpr size_t WS_REGB = WS_REGA + (size_t)R_ALL * ZC * 2;
constexpr size_t WS_END = WS_REGB + (size_t)R_TOK * 2048 * 2;
static_assert(WS_BBAR + 64 * 64 * 32 * 4 <= WS_W, "small tables");
static_assert((size_t)R_PAD * FF * 2 <= (size_t)R_ALL * ZC * 2, "HID fits REGA");
static_assert(WS_END <= 268435456, "workspace map must fit 256 MiB");
constexpr int CW_BAR = 4096;
constexpr int LDS_BYTES = 147456, MISC_OFF = 143360;

#define LDS_WAIT() asm volatile("s_waitcnt lgkmcnt(0)" ::: "memory")
#define VM_WAIT() asm volatile("s_waitcnt vmcnt(0)" ::: "memory")
__device__ __forceinline__ unsigned f2bf(float f) { unsigned u = __builtin_bit_cast(unsigned, f); return (u + 0x7fffu + ((u >> 16) & 1u)) >> 16; }
__device__ __forceinline__ unsigned pk2(float lo, float hi) { return f2bf(lo) | (f2bf(hi) << 16); }
__device__ __forceinline__ float bf2f(unsigned short h) { return __builtin_bit_cast(float, (unsigned)h << 16); }
__device__ __forceinline__ float bflo(unsigned w) { return __builtin_bit_cast(float, w << 16); }
__device__ __forceinline__ float bfhi(unsigned w) { return __builtin_bit_cast(float, w & 0xffff0000u); }
__device__ __forceinline__ float fast_exp(float x) { return __builtin_amdgcn_exp2f(x * 1.44269504089f); }
__device__ __forceinline__ float sigmoidf(float x) { return __builtin_amdgcn_rcpf(1.0f + fast_exp(-x)); }
__device__ __forceinline__ float siluf(float x) { return x * sigmoidf(x); }
__device__ __forceinline__ float gelu_tanh(float x) { const float u = 0.7978845608f * (x + 0.044715f * x * x * x); return x * sigmoidf(2.0f * u); }
__device__ __forceinline__ float wave_sum(float v) {
#pragma unroll
    for (int o = 1; o < 64; o <<= 1) v += __shfl_xor(v, o);
    return v;
}

namespace pg8 {
constexpr int BM = 256, BK = 64, HALF = 128, HTB = HALF * BK * 2, STAGE_BYTES = 8 * HTB, NXCD = 8, WGM = 8;
__host__ __device__ __forceinline__ int lds_byte(int r, int c) { const int st = (r >> 4) * 2 + (c >> 5), rr = r & 15, cc = c & 31, ob = rr * 64 + cc * 2; return st * 1024 + (ob ^ (((ob >> 9) & 1) << 5)); }
__host__ __device__ __forceinline__ void stage_rc(int b, int& R, int& C) { const int st = b / 1024, sb = b % 1024, swz = sb ^ (((sb >> 9) & 1) << 5); R = (st >> 1) * 16 + swz / 64; C = (st & 1) * 32 + (swz % 64) / 2; }
__host__ __device__ __forceinline__ int perm32(int rho) { const int n = rho >> 4, i = rho & 15; return 8 * (i >> 2) + 4 * n + (i & 3); }

struct Unit { int pm, pn; };
struct Gemm { const bf16_t* A; const bf16_t* Bt; int M, N, K, lda; };

struct StaticOrder {
    int nM, nN, nwg, G, c;
    __device__ void init(int M, int N, int G_, int c_) { nM = M / BM; nN = N / BM; nwg = nM * nN; G = G_; c = c_; }
    __device__ bool next(int i, Unit& u) const {
        const long L = (long)i * G + c; if (L >= nwg) return false;
        int wgid = (int)L; { const int q = nwg / NXCD, r = nwg % NXCD, xcd = wgid % NXCD, off = wgid / NXCD; wgid = (xcd < r ? xcd * (q + 1) : r * (q + 1) + (xcd - r) * q) + off; }
        const int nig = WGM * nN, gid = wgid / nig, fm = gid * WGM, gsz = (nM - fm) < WGM ? (nM - fm) : WGM;
        u.pm = fm + ((wgid % nig) % gsz); u.pn = (wgid % nig) / gsz; return true;
    }
};

template <class Epi>
__device__ __forceinline__ void gemm_phase(LAS unsigned char* lds, const Gemm g, const StaticOrder& S, const Epi& E) {
    const int tid = threadIdx.x, wid = __builtin_amdgcn_readfirstlane(tid >> 6), lane = tid & 63, wr = wid >> 2, wc = wid & 3, fr = lane & 15, fq = lane >> 4;
    const int K = g.K, nt = K / BK;
    unsigned voffA[2], voffB[2];
#pragma unroll
    for (int i = 0; i < 2; ++i) { int R, C; stage_rc(tid * 16 + i * 8192, R, C); const int Rb = (R & ~31) + perm32(R & 31);
        voffA[i] = (unsigned)(R * g.lda + C) * 2u; voffB[i] = (unsigned)(Rb * K + C) * 2u; }
    const size_t kstep = (size_t)(BK * 2);
    const size_t hstepA = (size_t)HALF * g.lda * 2, tstepA = 2 * hstepA;
    const size_t hstepB = (size_t)HALF * K * 2, tstepB = 2 * hstepB;
    const unsigned ldsw = (unsigned)wid * 1024u;
    const int aoff = lds_byte(wr * 64 + fr, fq * 8), boff = lds_byte(wc * 32 + fr, fq * 8);
#define PG8_SA(b, h) (((b) * 2 + (h)) * HTB)
#define PG8_SB(b, h) ((4 + (b) * 2 + (h)) * HTB)
#define PG8_STAGE(bufoff, gbase, voff) do { _Pragma("unroll") for (int _i = 0; _i < 2; ++_i) \
        __builtin_amdgcn_global_load_lds((const unsigned*)((const char*)(gbase) + (voff)[_i]), (LAS unsigned*)(lds + (bufoff) + ldsw + _i * 8192), 16, 0, 0); } while (0)
#define PG8_LDA(dst, b, h) do { _Pragma("unroll") for (int m = 0; m < 4; ++m) _Pragma("unroll") for (int k = 0; k < 2; ++k) dst[m][k] = *(const LAS bf16x8*)(lds + PG8_SA(b, h) + aoff + m * 2048 + k * 1024); } while (0)
#define PG8_LDB(dst, b, h) do { _Pragma("unroll") for (int n = 0; n < 2; ++n) _Pragma("unroll") for (int k = 0; k < 2; ++k) dst[n][k] = *(const LAS bf16x8*)(lds + PG8_SB(b, h) + boff + n * 2048 + k * 1024); } while (0)
#define PG8_MMA(ai, bj, At, Bt) do { __builtin_amdgcn_s_setprio(1); _Pragma("unroll") for (int m = 0; m < 4; ++m) _Pragma("unroll") for (int n = 0; n < 2; ++n) _Pragma("unroll") for (int k = 0; k < 2; ++k) \
        acc[ai][bj][m][n] = __builtin_amdgcn_mfma_f32_16x16x32_bf16(Bt[n][k], At[m][k], acc[ai][bj][m][n], 0, 0, 0); __builtin_amdgcn_s_setprio(0); } while (0)
#define PG8_WAIT_V(n) asm volatile("s_waitcnt vmcnt(" #n ")" ::: "memory")
#define PG8_WAIT_L(n) asm volatile("s_waitcnt lgkmcnt(" #n ")" ::: "memory")
#define PG8_BAR __builtin_amdgcn_s_barrier()
#define PG8_SCHED __builtin_amdgcn_sched_barrier(0)
    Unit cur, nxt; int ui = 0;
    if (!S.next(0, cur)) return;
    f32x4 acc[2][2][4][2];
#pragma unroll
    for (int a = 0; a < 2; ++a)
#pragma unroll
        for (int b = 0; b < 2; ++b)
#pragma unroll
            for (int m = 0; m < 4; ++m)
#pragma unroll
                for (int n = 0; n < 2; ++n) acc[a][b][m][n] = (f32x4){0.f, 0.f, 0.f, 0.f};
    bf16x8 At[4][2], B0[2][2], B1[2][2];
    const char* cA = (const char*)g.A + (size_t)cur.pm * tstepA; const char* cB = (const char*)g.Bt + (size_t)cur.pn * tstepB;
    PG8_STAGE(PG8_SB(0, 0), cB, voffB); PG8_STAGE(PG8_SB(0, 1), cB + hstepB, voffB); PG8_STAGE(PG8_SA(0, 0), cA, voffA); PG8_STAGE(PG8_SA(0, 1), cA + hstepA, voffA);
    if (wr == 1) PG8_BAR;
    PG8_WAIT_V(2); PG8_BAR;
    PG8_STAGE(PG8_SB(1, 0), cB + kstep, voffB); PG8_STAGE(PG8_SA(1, 0), cA + kstep, voffA); PG8_STAGE(PG8_SB(1, 1), cB + hstepB + kstep, voffB);
    PG8_WAIT_V(6); PG8_BAR;
    for (;;) {
        const bool has_next = S.next(ui + 1, nxt);
        const char* nA = has_next ? (const char*)g.A + (size_t)nxt.pm * tstepA : cA; const char* nB = has_next ? (const char*)g.Bt + (size_t)nxt.pn * tstepB : cB;
        for (int t = 0; t < nt; t += 2) {
            const bool last = (t == nt - 2);
            const char* a1 = cA + (size_t)(t + 1) * kstep;
            const char* a2 = last ? nA : cA + (size_t)(t + 2) * kstep; const char* b2 = last ? nB : cB + (size_t)(t + 2) * kstep;
            const char* a3 = a2 + kstep; const char* b3 = b2 + kstep;
            PG8_LDB(B0, 0, 0); PG8_LDB(B1, 0, 1); PG8_SCHED; PG8_LDA(At, 0, 0); PG8_STAGE(PG8_SA(1, 1), a1 + hstepA, voffA);
            PG8_WAIT_V(8); PG8_WAIT_L(0); PG8_BAR; PG8_MMA(0, 0, At, B0); PG8_MMA(0, 1, At, B1); PG8_BAR; PG8_SCHED;
            PG8_LDA(At, 0, 1); PG8_STAGE(PG8_SB(0, 0), b2, voffB); PG8_STAGE(PG8_SB(0, 1), b2 + hstepB, voffB); PG8_STAGE(PG8_SA(0, 0), a2, voffA);
            PG8_WAIT_V(8); PG8_WAIT_L(0); PG8_BAR; PG8_MMA(1, 0, At, B0); PG8_MMA(1, 1, At, B1); PG8_BAR; PG8_SCHED;
            PG8_LDB(B0, 1, 0); PG8_LDB(B1, 1, 1); PG8_SCHED; PG8_LDA(At, 1, 0); PG8_STAGE(PG8_SA(0, 1), a2 + hstepA, voffA);
            PG8_WAIT_V(8); PG8_WAIT_L(0); PG8_BAR; PG8_MMA(0, 0, At, B0); PG8_MMA(0, 1, At, B1); PG8_BAR; PG8_SCHED;
            PG8_LDA(At, 1, 1); PG8_STAGE(PG8_SB(1, 0), b3, voffB); PG8_STAGE(PG8_SB(1, 1), b3 + hstepB, voffB); PG8_STAGE(PG8_SA(1, 0), a3, voffA);
            PG8_WAIT_V(8); PG8_WAIT_L(0); PG8_BAR; PG8_MMA(1, 0, At, B0); PG8_MMA(1, 1, At, B1); PG8_BAR; PG8_SCHED;
        }
        if (wr == 0) PG8_BAR;
        E(acc, cur, wr, wc, fr, fq);
        if (!has_next) break;
#pragma unroll
        for (int a = 0; a < 2; ++a)
#pragma unroll
            for (int b = 0; b < 2; ++b)
#pragma unroll
                for (int m = 0; m < 4; ++m)
#pragma unroll
                    for (int n = 0; n < 2; ++n) acc[a][b][m][n] = (f32x4){0.f, 0.f, 0.f, 0.f};
        cur = nxt; cA = nA; cB = nB; ++ui;
        if (wr == 1) PG8_BAR;
    }
    PG8_WAIT_V(0);
    PG8_BAR;
#undef PG8_SA
#undef PG8_SB
#undef PG8_STAGE
#undef PG8_LDA
#undef PG8_LDB
#undef PG8_MMA
#undef PG8_WAIT_V
#undef PG8_WAIT_L
#undef PG8_BAR
#undef PG8_SCHED
}

__device__ __forceinline__ float row_rstd(const float* ssq, int row) {
    const f32x4* p = (const f32x4*)(ssq + (size_t)row * 16); const f32x4 a = p[0], b = p[1], c = p[2], d = p[3];
    const float s = ((a.x + a.y) + (a.z + a.w)) + ((b.x + b.y) + (b.z + b.w)) + ((c.x + c.y) + (c.z + c.w)) + ((d.x + d.y) + (d.z + d.w));
    return __builtin_amdgcn_rsqf(s * (1.0f / 1024.0f) + EPS);
}
struct EpiGU {
    bf16_t* O; int ldo; const float* ssq;
    __device__ __forceinline__ void operator()(const f32x4 (&acc)[2][2][4][2], const Unit& u, int wr, int wc, int fr, int fq) const {
        const int col0 = u.pn * 128 + wc * 32 + 8 * fq;
#pragma unroll
        for (int ai = 0; ai < 2; ++ai)
#pragma unroll
            for (int m = 0; m < 4; ++m) { const int row = u.pm * BM + ai * HALF + wr * 64 + m * 16 + fr; const float rs = row_rstd(ssq, row);
                u32x4 w; unsigned* wp = (unsigned*)&w;
#pragma unroll
                for (int n = 0; n < 2; ++n) { const f32x4 gt = acc[ai][0][m][n] * rs, up = acc[ai][1][m][n] * rs;
                    wp[2 * n] = pk2(siluf(gt[0]) * up[0], siluf(gt[1]) * up[1]); wp[2 * n + 1] = pk2(siluf(gt[2]) * up[2], siluf(gt[3]) * up[3]); }
                *(u32x4*)(O + (size_t)row * ldo + col0) = w; }
    }
};
struct EpiRes {
    int mode;
    const float* xp; const float* xs; const float* meta; float* H; bf16_t* XB; float* ssq; float alpha;
    __device__ __forceinline__ void operator()(const f32x4 (&acc)[2][2][4][2], const Unit& u, int wr, int wc, int fr, int fq) const {
#pragma unroll
        for (int ai = 0; ai < 2; ++ai)
#pragma unroll
            for (int m = 0; m < 4; ++m) { const int row = u.pm * BM + ai * HALF + wr * 64 + m * 16 + fr;
                const float* bp;
                if (mode == 1) bp = H + (size_t)row * D;
                else bp = row < R_PROMPT ? xp + (size_t)row * D : row < R_TOK ? xs + (size_t)(row - R_PROMPT) * D : row < R_ALL ? meta + (size_t)(row - R_TOK) * D : nullptr;
                float ss = 0.f;
#pragma unroll
                for (int bj = 0; bj < 2; ++bj) { const int col = u.pn * BM + bj * HALF + wc * 32 + 8 * fq; f32x4 o[2];
#pragma unroll
                    for (int n = 0; n < 2; ++n) { const f32x4 b = bp ? *(const f32x4*)(bp + col + 4 * n) : (f32x4){0.f, 0.f, 0.f, 0.f}; o[n] = b + acc[ai][bj][m][n] * alpha;
                        if (row < R_TOK) *(f32x4*)(H + (size_t)row * D + col + 4 * n) = o[n];
                        ss += (o[n][0] * o[n][0] + o[n][1] * o[n][1]) + (o[n][2] * o[n][2] + o[n][3] * o[n][3]); }
                    if (XB) { u32x4 w; w.x = pk2(o[0][0], o[0][1]); w.y = pk2(o[0][2], o[0][3]); w.z = pk2(o[1][0], o[1][1]); w.w = pk2(o[1][2], o[1][3]); *(u32x4*)(XB + (size_t)row * D + col) = w; } }
                ss += __shfl_xor(ss, 16); ss += __shfl_xor(ss, 32);
                if (fq == 0) ssq[(size_t)row * 16 + u.pn * 4 + wc] = ss; }
    }
};
struct EpiZ {
    bf16_t* Z; bf16_t* G; float* GLR; const float* ssq;
    __device__ __forceinline__ void operator()(const f32x4 (&acc)[2][2][4][2], const Unit& u, int wr, int wc, int fr, int fq) const {
        const int pn = u.pn;
#pragma unroll
        for (int ai = 0; ai < 2; ++ai)
#pragma unroll
            for (int m = 0; m < 4; ++m) { const int row = u.pm * BM + ai * HALF + wr * 64 + m * 16 + fr; const float rs = row_rstd(ssq, row);
                if (pn == 24) {
                    if (wc == 0 && fq < 2 && row < R_ALL) { *(f32x4*)(GLR + (size_t)row * 16 + 8 * fq) = acc[ai][0][m][0] * rs; *(f32x4*)(GLR + (size_t)row * 16 + 8 * fq + 4) = acc[ai][0][m][1] * rs; }
                    continue; }
#pragma unroll
                for (int bj = 0; bj < 2; ++bj) { f32x4 v0 = acc[ai][bj][m][0] * rs, v1 = acc[ai][bj][m][1] * rs;
                    if (pn < 2) { v0 = v0 * 0.08838834764831845f; v1 = v1 * 0.08838834764831845f; }
                    else if (pn >= 8 && pn < 12) {
#pragma unroll
                        for (int j = 0; j < 4; ++j) { v0[j] = siluf(v0[j]); v1[j] = siluf(v1[j]); } }
                    else if (pn >= 16) {
#pragma unroll
                        for (int j = 0; j < 4; ++j) { v0[j] = sigmoidf(v0[j]); v1[j] = sigmoidf(v1[j]); } }
                    u32x4 w; w.x = pk2(v0[0], v0[1]); w.y = pk2(v0[2], v0[3]); w.z = pk2(v1[0], v1[1]); w.w = pk2(v1[2], v1[3]);
                    const int cc = bj * HALF + wc * 32 + 8 * fq;
                    if (pn < 16) { if (row < R_ALL) *(u32x4*)(Z + (size_t)row * ZC + pn * BM + cc) = w; }
                    else { if (row < R_TOK) *(u32x4*)(G + (size_t)row * 2048 + (pn - 16) * BM + cc) = w; } } }
    }
};
struct EpiGLU {
    const bf16_t* G; bf16_t* TMP;
    __device__ __forceinline__ void operator()(const f32x4 (&acc)[2][2][4][2], const Unit& u, int wr, int wc, int fr, int fq) const {
        const int col0 = u.pn * 128 + wc * 32 + 8 * fq;
#pragma unroll
        for (int ai = 0; ai < 2; ++ai)
#pragma unroll
            for (int m = 0; m < 4; ++m) { const int row = u.pm * BM + ai * HALF + wr * 64 + m * 16 + fr;
                const u32x4 gb = *(const u32x4*)(G + (size_t)row * 2048 + 1024 + col0); const unsigned* gp = (const unsigned*)&gb;
                u32x4 w; unsigned* wp = (unsigned*)&w;
#pragma unroll
                for (int n = 0; n < 2; ++n) { const f32x4 a = acc[ai][0][m][n], b = acc[ai][1][m][n];
                    wp[2 * n] = pk2(a[0] * sigmoidf(b[0]) * bflo(gp[2 * n]), a[1] * sigmoidf(b[1]) * bfhi(gp[2 * n]));
                    wp[2 * n + 1] = pk2(a[2] * sigmoidf(b[2]) * bflo(gp[2 * n + 1]), a[3] * sigmoidf(b[3]) * bfhi(gp[2 * n + 1])); }
                *(u32x4*)(TMP + (size_t)row * ZC + col0) = w; }
    }
};
struct EpiGO {
    const bf16_t* G; const bf16_t* TMP; bf16_t* MG;
    __device__ __forceinline__ void operator()(const f32x4 (&acc)[2][2][4][2], const Unit& u, int wr, int wc, int fr, int fq) const {
#pragma unroll
        for (int ai = 0; ai < 2; ++ai)
#pragma unroll
            for (int m = 0; m < 4; ++m) { const int row = u.pm * BM + ai * HALF + wr * 64 + m * 16 + fr;
#pragma unroll
                for (int bj = 0; bj < 2; ++bj) { const int col = u.pn * BM + bj * HALF + wc * 32 + 8 * fq;
                    const u32x4 ga = *(const u32x4*)(G + (size_t)row * 2048 + col), tp = *(const u32x4*)(TMP + (size_t)row * ZC + col);
                    const unsigned* gp = (const unsigned*)&ga; const unsigned* tpp = (const unsigned*)&tp; u32x4 w; unsigned* wp = (unsigned*)&w;
#pragma unroll
                    for (int n = 0; n < 2; ++n) { const f32x4 a = acc[ai][bj][m][n];
                        wp[2 * n] = pk2(a[0] * bflo(gp[2 * n]) + bflo(tpp[2 * n]), a[1] * bfhi(gp[2 * n]) + bfhi(tpp[2 * n]));
                        wp[2 * n + 1] = pk2(a[2] * bflo(gp[2 * n + 1]) + bflo(tpp[2 * n + 1]), a[3] * bfhi(gp[2 * n + 1]) + bfhi(tpp[2 * n + 1])); }
                    *(u32x4*)(MG + (size_t)row * ZC + col) = w; } }
    }
};
}

#define XB_TMO      128
#define XB_XCNT(j)  (256  + 64 * (j))
#define XB_XSUB(j)  (1280 + 64 * (j))
#define XB_XGEN(j)  (2304 + 64 * (j))
#define XB_TOP      3328
#define XB_TOPGEN   3392
#define XCD_BAR_WORDS 3456
#define XB_SPIN_CAP (1u << 18)
__device__ __forceinline__ unsigned xb_ld(unsigned* p)              { return __hip_atomic_load(p, __ATOMIC_RELAXED, __HIP_MEMORY_SCOPE_AGENT); }
__device__ __forceinline__ unsigned xb_add(unsigned* p, unsigned v) { return __hip_atomic_fetch_add(p, v, __ATOMIC_RELAXED, __HIP_MEMORY_SCOPE_AGENT); }
__device__ __forceinline__ unsigned xb_xcc_id() { return (unsigned)__builtin_amdgcn_s_getreg((3 << 11) | 20) & 0xFu; }
#define XB_SPIN(cond, bar) do { unsigned _sp = 0; while (cond) { __builtin_amdgcn_s_sleep(1); \
    if ((++_sp & 255u) == 0u) { if (xb_ld(&(bar)[XB_TMO])) break; if (_sp > XB_SPIN_CAP) { atomicAdd(&(bar)[XB_TMO], 1u); break; } } } } while (0)
struct XcdBarrier { unsigned* bar; unsigned x; volatile LAS unsigned* st; };
__device__ __forceinline__ XcdBarrier xcd_barrier_post(unsigned* bar, volatile LAS unsigned* st) {
    XcdBarrier b; b.bar = bar; b.x = xb_xcc_id(); b.st = st;
    if (threadIdx.x == 0) (void)xb_add(&bar[XB_XCNT(b.x)], 1u);
    return b;
}
__device__ __forceinline__ void xcd_barrier_complete(unsigned* bar, unsigned x, unsigned& nloc, unsigned& nx) {
    const unsigned G = gridDim.x * gridDim.y * gridDim.z;
    unsigned sum, cnt, mine, sp = 0u;
    for (;;) {
        sum = 0u; cnt = 0u; mine = 0u;
#pragma unroll
        for (unsigned j = 0; j < 16; ++j) { const unsigned c = xb_ld(&bar[XB_XCNT(j)]); sum += c; cnt += (c > 0u) ? 1u : 0u; mine = (j == x) ? c : mine; }
        if (sum == G) break;
        __builtin_amdgcn_s_sleep(1);
        if ((++sp & 255u) == 0u) { if (xb_ld(&bar[XB_TMO])) break; if (sp > XB_SPIN_CAP) { atomicAdd(&bar[XB_TMO], 1u); break; } }
    }
    nloc = mine > 0u ? mine : 1u; nx = cnt > 0u ? cnt : 1u;
}
__device__ __forceinline__ void xcd_barrier(const XcdBarrier& b) {
    asm volatile("s_waitcnt vmcnt(0)" ::: "memory");
    __syncthreads();
    if (threadIdx.x == 0) {
        unsigned* bar = b.bar;
        __builtin_amdgcn_s_waitcnt(0);
        unsigned nloc = b.st[0], nx = b.st[1];
        if (nloc == 0u) { xcd_barrier_complete(bar, b.x, nloc, nx); b.st[0] = nloc; b.st[1] = nx; }
        const unsigned old = xb_add(&bar[XB_XSUB(b.x)], 1u);
        const unsigned gen = old / nloc;
        if (old + 1u == (gen + 1u) * nloc) {
            __builtin_amdgcn_fence(__ATOMIC_RELEASE, "agent");
            asm volatile("s_waitcnt vmcnt(0)" ::: "memory");
            const unsigned og = xb_add(&bar[XB_TOP], 1u);
            const unsigned tg = og / nx;
            if (og + 1u == (tg + 1u) * nx) xb_add(&bar[XB_TOPGEN], 1u);
            else XB_SPIN(xb_ld(&bar[XB_TOPGEN]) == tg, bar);
            __builtin_amdgcn_fence(__ATOMIC_ACQUIRE, "agent");
            xb_add(&bar[XB_XGEN(b.x)], 1u);
            asm volatile("s_waitcnt vmcnt(0)" ::: "memory");
        } else {
            XB_SPIN(xb_ld(&bar[XB_XGEN(b.x)]) == gen, bar);
            __builtin_amdgcn_fence(__ATOMIC_ACQUIRE, "agent");
            asm volatile("s_waitcnt vmcnt(0)" ::: "memory");
        }
    }
    __syncthreads();
}

struct Args {
    const float* in[32]; float* out; unsigned char* ws; int ph_lo, ph_hi;
};
struct Frame {
    LAS unsigned char* lds; int tid, lane, wave, G, bid;
    const float* const* in;
    float* out; unsigned char* ws;
    float* H;
    bf16_t* XB;
    bf16_t* XB2;
    bf16_t* HID;
    bf16_t* Z;
    bf16_t* GT;
    float* SSQ; float* GLR; float* ABAR; float* BBAR;
};
enum { I_XP = 0, I_XS, I_SGLA, I_S5RE, I_S5IM, I_META, I_NFFN1, I_F1G, I_F1U, I_F1D, I_NMIX, I_WIN, I_GUP, I_GB, I_GNORM, I_GWO, I_ARE, I_AIM, I_LOGDT, I_BRE, I_BIM, I_CRE, I_CIM, I_S5D,
       I_GLUA, I_GLUB, I_WOUT, I_NFFN2, I_F2G, I_F2U, I_F2D, I_NFINAL };

__device__ __forceinline__ void conv_block(const float* W, int ldw, int c0, int nvalid, const float* gain, bf16_t* dst, int K, int n0, int k0, LAS float* scr, int lane) {
    const int cl = lane & 31;
#pragma unroll 8
    for (int i = 0; i < 32; ++i) { const int kk = 2 * i + (lane >> 5); float v = 0.f;
        if (cl < nvalid) { v = W[(size_t)(k0 + kk) * ldw + c0 + cl]; if (gain) v *= gain[k0 + kk]; }
        scr[kk * 33 + cl] = v; }
    LDS_WAIT(); asm volatile("" ::: "memory");
    const int c = lane & 7;
#pragma unroll
    for (int j = 0; j < 4; ++j) { const int n = (lane >> 3) + 8 * j; const LAS float* s = scr + (8 * c) * 33 + n;
        u32x4 o; o.x = pk2(s[0 * 33], s[1 * 33]); o.y = pk2(s[2 * 33], s[3 * 33]); o.z = pk2(s[4 * 33], s[5 * 33]); o.w = pk2(s[6 * 33], s[7 * 33]);
        *(u32x4*)(dst + (size_t)(n0 + n) * K + k0 + 8 * c) = o; }
    LDS_WAIT(); asm volatile("" ::: "memory");
}
__device__ __forceinline__ double dexp(double x) {
    const double n = __builtin_rint(x * 1.4426950408889634); const double f = x - n * 0.6931471805599453094;
    double t = 1.0, s = 1.0;
#pragma unroll
    for (int i = 1; i <= 16; ++i) { t = t * f / (double)i; s += t; }
    const long long bits = (long long)(1023 + (int)n) << 52; return s * __builtin_bit_cast(double, bits);
}
__device__ __forceinline__ void dsincos(double x, double& sn, double& cs) {
    const double k = __builtin_rint(x * 0.6366197723675814); const double r = (x - k * 1.5707963267948966) - k * 6.123233995736766e-17;
    const double r2 = r * r; double ts = r, ss = r, tc = 1.0, sc = 1.0;
#pragma unroll
    for (int i = 1; i <= 9; ++i) { ts = -ts * r2 / (double)((2 * i) * (2 * i + 1)); ss += ts; tc = -tc * r2 / (double)((2 * i - 1) * (2 * i)); sc += tc; }
    const int q = ((int)k) & 3;
    sn = (q == 0) ? ss : (q == 1) ? sc : (q == 2) ? -ss : -sc;
    cs = (q == 0) ? sc : (q == 1) ? -ss : (q == 2) ? -sc : ss;
}
__device__ __forceinline__ void p0_prologue(Frame& F) {
    LAS float* scr = (LAS float*)(F.lds + F.wave * 16384);
    const int gw = F.bid * 8 + F.wave, NGW = F.G * 8;
    const float* const* in = F.in;
    bf16_t* WT1 = (bf16_t*)(F.ws + WS_WT1); bf16_t* WD1 = (bf16_t*)(F.ws + WS_WD1); bf16_t* WIN = (bf16_t*)(F.ws + WS_WIN); bf16_t* WGO = (bf16_t*)(F.ws + WS_WGO);
    bf16_t* WGLU = (bf16_t*)(F.ws + WS_WGLU); bf16_t* WO = (bf16_t*)(F.ws + WS_WO); bf16_t* WT2 = (bf16_t*)(F.ws + WS_WT2); bf16_t* WD2 = (bf16_t*)(F.ws + WS_WD2);
    constexpr int I_GU = 16 * 176, I_DN = 44 * 32, I_IN = 16 * 200, I_SQ = 16 * 32, I_GL = 16 * 64;
    constexpr int NITEMS = 2 * I_GU + 2 * I_DN + I_IN + 2 * I_SQ + I_GL;
    for (int it = gw; it < NITEMS; it += NGW) {
        int r = it;
        if (r < 2 * I_GU) {
            const int second = r >= I_GU; if (second) r -= I_GU;
            const int nb = r % 176, kb = r / 176, n0 = 32 * nb, t = n0 >> 8, bj = (n0 >> 7) & 1, j = n0 & 127;
            const float* W = in[second ? (bj ? I_F2U : I_F2G) : (bj ? I_F1U : I_F1G)];
            conv_block(W, FF, 128 * t + j, 32, in[second ? I_NFFN2 : I_NFFN1], second ? WT2 : WT1, D, n0, 64 * kb, scr, F.lane); continue; }
        r -= 2 * I_GU;
        if (r < 2 * I_DN) { const int second = r >= I_DN; if (second) r -= I_DN; const int nb = r % 32, kb = r / 32;
            conv_block(in[second ? I_F2D : I_F1D], D, 32 * nb, 32, nullptr, second ? WD2 : WD1, FF, 32 * nb, 64 * kb, scr, F.lane); continue; }
        r -= 2 * I_DN;
        if (r < I_IN) { const int nb = r % 200, kb = r / 200, n0 = 32 * nb; int c0, nv;
            if (n0 < 3072) { c0 = n0; nv = 32; } else if (n0 < 6144) { c0 = n0 + 16; nv = 32; } else if (n0 == 6144) { c0 = 3072; nv = 16; } else { c0 = 0; nv = 0; }
            conv_block(in[I_WIN], 6160, c0, nv, in[I_NMIX], WIN, D, n0, 64 * kb, scr, F.lane); continue; }
        r -= I_IN;
        if (r < I_SQ) { const int nb = r % 32, kb = r / 32; conv_block(in[I_GWO], D, 32 * nb, 32, in[I_GNORM], WGO, D, 32 * nb, 64 * kb, scr, F.lane); continue; }
        r -= I_SQ;
        if (r < I_SQ) { const int nb = r % 32, kb = r / 32; conv_block(in[I_WOUT], D, 32 * nb, 32, nullptr, WO, D, 32 * nb, 64 * kb, scr, F.lane); continue; }
        r -= I_SQ;
        { const int nb = r % 64, kb = r / 64, n0 = 32 * nb, t = n0 >> 8, bj = (n0 >> 7) & 1, j = n0 & 127;
          conv_block(in[bj ? I_GLUB : I_GLUA], D, 128 * t + j, 32, nullptr, WGLU, D, n0, 64 * kb, scr, F.lane); }
    }
    for (int m = gw; m < R_PAD; m += NGW) {
        const float* xr = m < R_PROMPT ? in[I_XP] + (size_t)m * D : m < R_TOK ? in[I_XS] + (size_t)(m - R_PROMPT) * D : m < R_ALL ? in[I_META] + (size_t)(m - R_TOK) * D : nullptr;
        f32x4 v[4]; float s = 0.f;
#pragma unroll
        for (int j = 0; j < 4; ++j) { v[j] = xr ? ((const f32x4*)xr)[F.lane + 64 * j] : (f32x4){0.f, 0.f, 0.f, 0.f}; s += (v[j].x * v[j].x + v[j].y * v[j].y) + (v[j].z * v[j].z + v[j].w * v[j].w); }
        s = wave_sum(s);
        u32x2* o8 = (u32x2*)(F.XB + (size_t)m * D) + F.lane;
#pragma unroll
        for (int j = 0; j < 4; ++j) { u32x2 w; w.x = pk2(v[j].x, v[j].y); w.y = pk2(v[j].z, v[j].w); o8[64 * j] = w; }
        if (F.lane < 16) F.SSQ[(size_t)m * 16 + F.lane] = F.lane == 0 ? s : 0.f;
    }
    for (int i = F.bid * 512 + F.tid; i < S5G * S5P; i += F.G * 512) {
        const int g = i >> 6;
        const double lre = (double)in[I_ARE][i], lim = (double)in[I_AIM][i], dt = dexp((double)in[I_LOGDT][g]);
        double sn, cs; dsincos(lim * dt, sn, cs); const double mag = dexp(lre * dt);
        const double are = mag * cs, aim = mag * sn;
        F.ABAR[2 * i] = (float)are; F.ABAR[2 * i + 1] = (float)aim;
        const double nr = are - 1.0, ni = aim, den = lre * lre + lim * lim;
        const double cr = (nr * lre + ni * lim) / den, cim = (ni * lre - nr * lim) / den;
        for (int c = 0; c < S5C; ++c) { const double br = (double)in[I_BRE][(size_t)i * S5C + c], bi = (double)in[I_BIM][(size_t)i * S5C + c];
            F.BBAR[(size_t)i * 32 + c] = (float)(cr * br - cim * bi); F.BBAR[(size_t)i * 32 + 16 + c] = (float)(cr * bi + cim * br); }
    }
}

__device__ __forceinline__ void p10_final(Frame& F) {
    const int gw = F.bid * 8 + F.wave, NGW = F.G * 8;
    const f32x4* gp = (const f32x4*)F.in[I_NFINAL];
    for (int m = gw; m < R_TOK; m += NGW) {
        const float rs = pg8::row_rstd(F.SSQ, m);
        f32x4* xr = (f32x4*)(F.H + (size_t)m * D);
#pragma unroll
        for (int j = 0; j < 4; ++j) { const f32x4 v = xr[F.lane + 64 * j]; xr[F.lane + 64 * j] = v * rs * gp[F.lane + 64 * j]; }
    }
}

#define MFMA32(a, b, c) __builtin_amdgcn_mfma_f32_32x32x16_bf16((a), (b), (c), 0, 0, 0)
#define MFMA16(a, b, c) __builtin_amdgcn_mfma_f32_16x16x32_bf16((a), (b), (c), 0, 0, 0)
__device__ __forceinline__ float log_sigmoid(float x) { return fminf(x, 0.f) - __logf(1.0f + __expf(-fabsf(x))); }
__device__ __forceinline__ int crow(int r, int hh) { return (r & 3) + 8 * (r >> 2) + 4 * hh; }

constexpr int GL_GLR = 0, GL_TOT = 4096, GL_QE = 8192, GL_KE = 25600, GL_P = 43008;
constexpr int QROW = 272, SROW = 144, OROW = 528;
constexpr size_t SC_P = WS_WT1, SC_DEC = SC_P + (size_t)1024 * 8192, SC_SMETA = SC_DEC + (size_t)1024 * 512 + 4096, SC_END = SC_SMETA + (size_t)4 * 128 * 256 * 4;
static_assert(SC_END <= WS_WIN, "GLA scratch must fit the dead FFN1 weight region");
__device__ __forceinline__ void gla_prep_unit(Frame& F, int b, int h, int c) {
    LAS unsigned char* lds = F.lds;
    const int tid = F.tid, lane = F.lane, w = F.wave, l31 = lane & 31, hh = lane >> 5;
    const int d = tid & 127, tq = __builtin_amdgcn_readfirstlane(tid >> 7);
    const int row0 = b * SEQ + 64 * c, cidx = (b * NH + h) * 32 + c;
    unsigned char* zq = (unsigned char*)(F.Z + (size_t)row0 * ZC + ZQ + h * 128);
    unsigned char* zk = (unsigned char*)(F.Z + (size_t)row0 * ZC + ZK + h * 128);
    unsigned char* zv = (unsigned char*)(F.Z + (size_t)row0 * ZC + ZV + h * 256);
    const float* Wup = F.in[I_GUP];
    float wup[16];
#pragma unroll
    for (int j = 0; j < 16; ++j) wup[j] = Wup[j * 512 + h * 128 + d];
    const float bg = F.in[I_GB][h * 128 + d];
    { const int t = tid >> 3, j2 = (tid & 7) * 2; *(LAS f32x2*)(lds + GL_GLR + (t * 16 + j2) * 4) = *(const f32x2*)(F.GLR + (size_t)(row0 + t) * 16 + j2); }
    unsigned qk[16];
#pragma unroll
    for (int i = 0; i < 16; ++i) { const bf16_t* zr = F.Z + (size_t)(row0 + 16 * tq + i) * ZC + h * 128 + d; qk[i] = (unsigned)zr[ZQ] | ((unsigned)zr[ZK] << 16); }
    unsigned pv[16];
    const int e = tid & 255, sh = __builtin_amdgcn_readfirstlane(tid >> 8);
#pragma unroll
    for (int i = 0; i < 16; ++i) { const bf16_t* vp = F.Z + (size_t)(row0 + 32 * sh + 2 * i) * ZC + ZV + h * 256 + e; pv[i] = (unsigned)vp[0] | ((unsigned)vp[ZC] << 16); }
    __syncthreads();
    float bl[16]; float run = 0.f;
#pragma unroll
    for (int i = 0; i < 16; ++i) { const int t = 16 * tq + i; float x = bg;
#pragma unroll
        for (int j4 = 0; j4 < 4; ++j4) { const f32x4 gv = *(const LAS f32x4*)(lds + GL_GLR + (t * 16 + 4 * j4) * 4);
            x += gv[0] * wup[4 * j4] + gv[1] * wup[4 * j4 + 1] + gv[2] * wup[4 * j4 + 2] + gv[3] * wup[4 * j4 + 3]; }
        run += log_sigmoid(x) * (1.0f / 16.0f); bl[i] = run; }
    *(LAS float*)(lds + GL_TOT + (tq * 128 + d) * 4) = run;
    VM_WAIT();
    __syncthreads();
    float offs = 0.f, blast = 0.f;
#pragma unroll
    for (int q = 0; q < 4; ++q) { const float v = *(const LAS float*)(lds + GL_TOT + (q * 128 + d) * 4); blast += v; if (q < tq) offs += v; }
    { unsigned kd[8];
#pragma unroll
      for (int i = 0; i < 16; i += 2) { float kdv[2];
#pragma unroll
          for (int u2 = 0; u2 < 2; ++u2) { const int t = 16 * tq + i + u2; const float bt = offs + bl[i + u2]; const float q = bflo(qk[i + u2]), k = bfhi(qk[i + u2]);
              const float qe = q * __expf(bt), ke = k * __expf(-bt); kdv[u2] = k * __expf(blast - bt);
              *(LAS unsigned short*)(lds + GL_QE + t * QROW + d * 2) = (unsigned short)f2bf(qe);
              *(LAS unsigned short*)(lds + GL_KE + t * QROW + d * 2) = (unsigned short)f2bf(ke); }
          kd[i >> 1] = pk2(kdv[0], kdv[1]); }
      const int sw = (d >> 1) & 7;
      { const int o = 128 * d + 16 * ((2 * tq) ^ sw); *(u32x4*)(zk + (size_t)(o >> 8) * (ZC * 2) + (o & 255)) = (u32x4){kd[0], kd[1], kd[2], kd[3]}; }
      { const int o = 128 * d + 16 * ((2 * tq + 1) ^ sw); *(u32x4*)(zk + (size_t)(o >> 8) * (ZC * 2) + (o & 255)) = (u32x4){kd[4], kd[5], kd[6], kd[7]}; }
      if (tq == 0) ((float*)(F.ws + SC_DEC))[(size_t)cidx * 128 + d] = __expf(blast); }
#pragma unroll
    for (int c4 = 0; c4 < 4; ++c4) { const int o = 128 * e + 16 * (4 * sh + c4); *(u32x4*)(zv + (size_t)(o >> 9) * (ZC * 2) + (o & 511)) = (u32x4){pv[4 * c4], pv[4 * c4 + 1], pv[4 * c4 + 2], pv[4 * c4 + 3]}; }
    __syncthreads();
    if (w < 4) { const int tr = w >> 1, sc = w & 1; f32x16 sa;
#pragma unroll
        for (int r = 0; r < 16; ++r) sa[r] = 0.f;
        if (sc <= tr) {
#pragma unroll
            for (int ks = 0; ks < 8; ++ks) { const bf16x8 a = *(const LAS bf16x8*)(lds + GL_QE + (32 * tr + l31) * QROW + (16 * ks + 8 * hh) * 2);
                const bf16x8 bb = *(const LAS bf16x8*)(lds + GL_KE + (32 * sc + l31) * QROW + (16 * ks + 8 * hh) * 2); sa = MFMA32(a, bb, sa); } }
#pragma unroll
        for (int r = 0; r < 16; ++r) { const int t = 32 * tr + crow(r, hh), s_ = 32 * sc + l31; const float v = (s_ <= t) ? sa[r] : 0.f;
            *(LAS unsigned short*)(lds + GL_P + t * SROW + s_ * 2) = (unsigned short)f2bf(v); } }
    { const int t = tid >> 3, j = tid & 7;
#pragma unroll
      for (int i = 0; i < 2; ++i) { const int cc = 2 * j + i; const u32x4 v = *(const LAS u32x4*)(lds + GL_QE + t * QROW + cc * 16); *(u32x4*)(zq + (size_t)t * (ZC * 2) + 16 * (cc ^ (t & 15))) = v; } }
    __syncthreads();
    { const int t = tid >> 3, j = tid & 7; const u32x4 v = *(const LAS u32x4*)(lds + GL_P + t * SROW + j * 16);
      *(u32x4*)(F.ws + SC_P + (size_t)cidx * 8192 + 128 * t + 16 * (j ^ ((t >> 1) & 7))) = v; }
    __syncthreads();
}
__device__ __forceinline__ void gla_meta_unit(Frame& F, int h) {
    LAS unsigned char* lds = F.lds; const int tid = F.tid;
    LAS float* KD = (LAS float*)lds; LAS float* VS = (LAS float*)(lds + 8192);
    if (tid < 128) { const int d = tid; float bsum = 0.f, bt[16], k[16];
        for (int t = 0; t < NMETA; ++t) { float x = F.in[I_GB][h * 128 + d];
            for (int j = 0; j < 16; ++j) x += F.GLR[(size_t)(R_META + t) * 16 + j] * F.in[I_GUP][j * 512 + h * 128 + d];
            bsum += log_sigmoid(x) * (1.0f / 16.0f); bt[t] = bsum; k[t] = bf2f(F.Z[(size_t)(R_META + t) * ZC + ZK + h * 128 + d]); }
        for (int t = 0; t < NMETA; ++t) KD[t * 128 + d] = k[t] * __expf(bsum - bt[t]); }
    for (int i = tid; i < NMETA * 256; i += 512) VS[i] = bf2f(F.Z[(size_t)(R_META + (i >> 8)) * ZC + ZV + h * 256 + (i & 255)]);
    __syncthreads();
    float* sm = (float*)(F.ws + SC_SMETA) + (size_t)h * DK * DV;
    for (int i = tid; i < DK * DV; i += 512) { const int d = i >> 8, e = i & 255; float a = 0.f;
#pragma unroll
        for (int t = 0; t < NMETA; ++t) a += KD[t * 128 + d] * VS[t * 256 + e];
        sm[i] = a; }
    __syncthreads();
}
constexpr int SQ_QE = 0, SQ_KDT = 16384, SQ_P = 32768, SQ_DEC = 40960, SQ_BUF = 41984, SQ_OT = 2 * SQ_BUF, SQ_END = SQ_OT + 64 * OROW;
static_assert(SQ_END <= MISC_OFF, "GLA seq LDS map");
__device__ __forceinline__ void gla_seq_unit(Frame& F, int b, int h) {
    LAS unsigned char* lds = F.lds;
    const int tid = F.tid, lane = F.lane, w = F.wave, l31 = lane & 31, hh = lane >> 5;
    f32x16 S[4];
    { const float* sm = (const float*)(F.ws + SC_SMETA) + (size_t)h * DK * DV + 4 * hh * DV + 32 * w + l31;
#pragma unroll
      for (int dr = 0; dr < 4; ++dr)
#pragma unroll
          for (int r = 0; r < 16; ++r) S[dr][r] = sm[(32 * dr + (r & 3) + 8 * (r >> 2)) * DV]; }
    const int cidx0 = (b * NH + h) * 32;
#define SQ_STAGE(c, bi) do { const size_t r0_ = (size_t)(b * SEQ + 64 * (c)); const unsigned char* zq_ = (const unsigned char*)(F.Z + r0_ * ZC + ZQ + h * 128); const unsigned char* zk_ = (const unsigned char*)(F.Z + r0_ * ZC + ZK + h * 128); \
        _Pragma("unroll") for (int p_ = 0; p_ < 2; ++p_) { const int o_ = p_ * 8192 + tid * 16; \
            __builtin_amdgcn_global_load_lds((const unsigned*)(zq_ + (size_t)(o_ >> 8) * (ZC * 2) + (o_ & 255)), (LAS unsigned*)(lds + (bi) * SQ_BUF + SQ_QE + p_ * 8192 + w * 1024), 16, 0, 0); \
            __builtin_amdgcn_global_load_lds((const unsigned*)(zk_ + (size_t)(o_ >> 8) * (ZC * 2) + (o_ & 255)), (LAS unsigned*)(lds + (bi) * SQ_BUF + SQ_KDT + p_ * 8192 + w * 1024), 16, 0, 0); } \
        __builtin_amdgcn_global_load_lds((const unsigned*)(F.ws + SC_P + (size_t)(cidx0 + (c)) * 8192 + tid * 16), (LAS unsigned*)(lds + (bi) * SQ_BUF + SQ_P + w * 1024), 16, 0, 0); \
        if (w == 0) __builtin_amdgcn_global_load_lds((const unsigned*)(F.ws + SC_DEC + (size_t)(cidx0 + (c)) * 512 + lane * 16), (LAS unsigned*)(lds + (bi) * SQ_BUF + SQ_DEC), 16, 0, 0); } while (0)
#define SQ_LOADV(c, vtd) do { const size_t r0_ = (size_t)(b * SEQ + 64 * (c)); const unsigned char* zv_ = (const unsigned char*)(F.Z + r0_ * ZC + ZV + h * 256); \
        _Pragma("unroll") for (int ks = 0; ks < 4; ++ks) { const int o_ = 128 * (32 * w + l31) + 32 * ks + 16 * hh; vtd[ks] = *(const bf16x8*)(zv_ + (size_t)(o_ >> 9) * (ZC * 2) + (o_ & 511)); } \
        } while (0)
#define SQ_LOADR(c, rrd) do { const u32x4* rp_ = (const u32x4*)(F.Z + ((size_t)(b * SEQ + 64 * (c)) + (tid >> 3)) * ZC + ZR + h * 256 + 32 * (tid & 7)); \
        _Pragma("unroll") for (int i = 0; i < 4; ++i) rrd[i] = rp_[i]; } while (0)
    bf16x8 vt[4], vtn[4]; u32x4 rr[4];
    SQ_STAGE(0, 0); SQ_LOADV(0, vt);
    for (int c = 0; c < 32; ++c) {
        const int bi = c & 1; LAS unsigned char* buf = lds + bi * SQ_BUF;
        VM_WAIT(); __syncthreads();
        if (c + 1 < 32) { SQ_STAGE(c + 1, bi ^ 1); SQ_LOADV(c + 1, vtn); }
        SQ_LOADR(c, rr);
        f32x16 oa[2];
#pragma unroll
        for (int tr = 0; tr < 2; ++tr) {
#pragma unroll
            for (int r = 0; r < 16; ++r) oa[tr][r] = 0.f;
#pragma unroll
            for (int ks = 0; ks < 4; ++ks) { if (tr == 0 && ks >= 2) continue; const int t = 32 * tr + l31;
                const bf16x8 a = *(const LAS bf16x8*)(buf + SQ_P + 128 * t + 16 * ((2 * ks + hh) ^ ((t >> 1) & 7))); oa[tr] = MFMA32(a, vt[ks], oa[tr]); } }
#pragma unroll
        for (int dr = 0; dr < 4; ++dr)
#pragma unroll
            for (int s2 = 0; s2 < 2; ++s2) { u32x4 bw; bw.x = pk2(S[dr][8 * s2 + 0], S[dr][8 * s2 + 1]); bw.y = pk2(S[dr][8 * s2 + 2], S[dr][8 * s2 + 3]);
                bw.z = pk2(S[dr][8 * s2 + 4], S[dr][8 * s2 + 5]); bw.w = pk2(S[dr][8 * s2 + 6], S[dr][8 * s2 + 7]); const bf16x8 bfrag = __builtin_bit_cast(bf16x8, bw);
#pragma unroll
                for (int tr = 0; tr < 2; ++tr) { const int t = 32 * tr + l31, ch = 4 * dr + 2 * s2;
                    const u32x2 a0 = *(const LAS u32x2*)(buf + SQ_QE + 256 * t + 16 * (ch ^ (t & 15)) + 8 * hh), a1 = *(const LAS u32x2*)(buf + SQ_QE + 256 * t + 16 * ((ch + 1) ^ (t & 15)) + 8 * hh);
                    const bf16x8 a = __builtin_bit_cast(bf16x8, (u32x4){a0.x, a0.y, a1.x, a1.y}); oa[tr] = MFMA32(a, bfrag, oa[tr]); }
                __builtin_amdgcn_sched_barrier(0); }
#pragma unroll
        for (int dr = 0; dr < 4; ++dr) {
            __builtin_amdgcn_sched_barrier(0);
#pragma unroll
            for (int g4 = 0; g4 < 4; ++g4) { const f32x4 dc = *(const LAS f32x4*)(buf + SQ_DEC + (32 * dr + 8 * g4 + 4 * hh) * 4);
#pragma unroll
                for (int q = 0; q < 4; ++q) S[dr][4 * g4 + q] *= dc[q]; }
#pragma unroll
            for (int ks = 0; ks < 4; ++ks) { const int d = 32 * dr + l31; const bf16x8 a = *(const LAS bf16x8*)(buf + SQ_KDT + 128 * d + 16 * ((2 * ks + hh) ^ ((d >> 1) & 7))); S[dr] = MFMA32(a, vt[ks], S[dr]); } }
#pragma unroll
        for (int tr = 0; tr < 2; ++tr)
#pragma unroll
            for (int r = 0; r < 16; ++r) *(LAS unsigned short*)(lds + SQ_OT + (32 * tr + crow(r, hh)) * OROW + (32 * w + l31) * 2) = (unsigned short)f2bf(oa[tr][r]);
        __syncthreads();
        { const int t = tid >> 3, j8 = tid & 7; float ss = 0.f;
#pragma unroll
          for (int i = 0; i < 4; ++i) { const u32x4 ow = *(const LAS u32x4*)(lds + SQ_OT + t * OROW + (32 * j8 + 8 * i) * 2); const unsigned* op = (const unsigned*)&ow;
#pragma unroll
              for (int q = 0; q < 4; ++q) { const float a = bflo(op[q]), cc = bfhi(op[q]); ss += a * a + cc * cc; } }
          ss += __shfl_xor(ss, 1); ss += __shfl_xor(ss, 2); ss += __shfl_xor(ss, 4);
          const float rs = __builtin_amdgcn_rsqf(ss * (1.0f / 256.0f) + EPS);
          u32x4* op = (u32x4*)(F.Z + (size_t)(b * SEQ + 64 * c + t) * ZC + ZR + h * 256 + 32 * j8);
#pragma unroll
          for (int i = 0; i < 4; ++i) { const u32x4 ow = *(const LAS u32x4*)(lds + SQ_OT + t * OROW + (32 * j8 + 8 * i) * 2); const unsigned* ovp = (const unsigned*)&ow;
              const unsigned* rp = (const unsigned*)&rr[i]; u32x4 ww; unsigned* wp = (unsigned*)&ww;
#pragma unroll
              for (int q = 0; q < 4; ++q) wp[q] = pk2(bflo(ovp[q]) * rs * bflo(rp[q]), bfhi(ovp[q]) * rs * bfhi(rp[q]));
              op[i] = ww; } }
#pragma unroll
        for (int i = 0; i < 4; ++i) vt[i] = vtn[i];
    }
#undef SQ_STAGE
#undef SQ_LOADV
#undef SQ_LOADR
    { int hh2 = hh, col2 = 32 * w + l31; asm volatile("" : "+v"(hh2), "+v"(col2));
      float* gs = F.out + O_GLAP + ((size_t)(b * NH + h) * DK) * DV + 4 * hh2 * DV + col2;
#pragma unroll
      for (int dr = 0; dr < 4; ++dr)
#pragma unroll
          for (int r = 0; r < 16; ++r) gs[(32 * dr + (r & 3) + 8 * (r >> 2)) * DV] = S[dr][r]; }
    __syncthreads();
}

constexpr int S5_HROW = 272, S5_HGRP = 32 * S5_HROW, S5_HBUF = 4 * S5_HGRP;
static_assert(2 * S5_HBUF <= MISC_OFF, "S5 LDS map");
__device__ __forceinline__ bf16x8 split_hi(const float (&x)[8], float (&rem)[8]) {
    unsigned w[4];
#pragma unroll
    for (int i = 0; i < 4; ++i) { const unsigned a = f2bf(x[2 * i]), c = f2bf(x[2 * i + 1]); rem[2 * i] = x[2 * i] - bflo(a); rem[2 * i + 1] = x[2 * i + 1] - bflo(c); w[i] = a | (c << 16); }
    return __builtin_bit_cast(bf16x8, (u32x4){w[0], w[1], w[2], w[3]});
}
__device__ __forceinline__ bf16x8 pack8(const float (&x)[8]) { return __builtin_bit_cast(bf16x8, (u32x4){pk2(x[0], x[1]), pk2(x[2], x[3]), pk2(x[4], x[5]), pk2(x[6], x[7])}); }
__device__ __forceinline__ void s5_prompt_unit(Frame& F, int b, int gq) {
    LAS unsigned char* lds = F.lds;
    const int lane = F.lane, w = F.wave, gi = w >> 1, pc = w & 1, g = 4 * gq + gi, l31 = lane & 31, hh = lane >> 5, p = 32 * pc + l31;
    const float are = F.ABAR[2 * (g * 64 + p)], aim = F.ABAR[2 * (g * 64 + p) + 1];
    bf16x8 brh, brl, bih, bil;
    { float x[8], rem[8];
#pragma unroll
      for (int j = 0; j < 8; ++j) x[j] = F.BBAR[(size_t)(g * 64 + p) * 32 + 8 * hh + j];
      brh = split_hi(x, rem); brl = pack8(rem);
#pragma unroll
      for (int j = 0; j < 8; ++j) x[j] = F.BBAR[(size_t)(g * 64 + p) * 32 + 16 + 8 * hh + j];
      bih = split_hi(x, rem); bil = pack8(rem); }
    bf16x8 cfr[4];
    { const int c = lane & 15, kq = lane >> 4;
#pragma unroll
      for (int ks = 0; ks < 4; ++ks) { float x[8]; const int p0 = 32 * ks + 8 * kq;
#pragma unroll
          for (int j = 0; j < 8; ++j) { const int pp = p0 + j; x[j] = pp < 64 ? F.in[I_CRE][(size_t)(g * 16 + c) * 64 + pp] : -F.in[I_CIM][(size_t)(g * 16 + c) * 64 + (pp - 64)]; }
          cfr[ks] = pack8(x); } }
    const float dco = F.in[I_S5D][g * 16 + (lane & 15)];
    float car = 0.f, cai = 0.f;
    for (int ci = 0; ci <= 64; ++ci) {
        const int row0 = ci == 0 ? R_META : b * SEQ + (ci - 1) * 32, nvalid = ci == 0 ? NMETA : 32;
        bf16x8 a = (bf16x8){0, 0, 0, 0, 0, 0, 0, 0};
        if (l31 < nvalid) a = *(const bf16x8*)(F.Z + (size_t)(row0 + l31) * ZC + ZU + 16 * g + 8 * hh);
        f32x16 hr, hi;
#pragma unroll
        for (int r = 0; r < 16; ++r) { hr[r] = 0.f; hi[r] = 0.f; }
        hr = MFMA32(a, brh, hr); hr = MFMA32(a, brl, hr); hi = MFMA32(a, bih, hi); hi = MFMA32(a, bil, hi);
#pragma unroll
        for (int j = 0; j < 4; ++j) { if (8 * j < nvalid) {
#pragma unroll
            for (int ph = 0; ph < 2; ++ph) { float cr = car, cim = cai;
#pragma unroll
                for (int q = 0; q < 4; ++q) { const int r = 4 * j + q; const float nr = are * cr - aim * cim + hr[r], ni = are * cim + aim * cr + hi[r];
                    hr[r] = (hh == ph) ? nr : hr[r]; hi[r] = (hh == ph) ? ni : hi[r]; cr = nr; cim = ni; }
                car = __shfl_xor(cr, 32); cai = __shfl_xor(cim, 32); } } }
        LAS unsigned char* hb = lds + (ci & 1) * S5_HBUF + gi * S5_HGRP;
#pragma unroll
        for (int r = 0; r < 16; ++r) { const int t = crow(r, hh);
            *(LAS unsigned short*)(hb + t * S5_HROW + p * 2) = (unsigned short)f2bf(hr[r]); *(LAS unsigned short*)(hb + t * S5_HROW + (64 + p) * 2) = (unsigned short)f2bf(hi[r]); }
        __syncthreads();
        if (ci > 0) { f32x4 y = (f32x4){0.f, 0.f, 0.f, 0.f}; const int c = lane & 15, kq = lane >> 4;
#pragma unroll
            for (int ks = 0; ks < 4; ++ks) { const bf16x8 af = *(const LAS bf16x8*)(hb + (16 * pc + c) * S5_HROW + (32 * ks + 8 * kq) * 2); y = MFMA16(af, cfr[ks], y); }
#pragma unroll
            for (int i = 0; i < 4; ++i) { bf16_t* zp = F.Z + (size_t)(row0 + 16 * pc + 4 * kq + i) * ZC + ZU + 16 * g + c; const float u = bf2f(*zp); *zp = (bf16_t)f2bf(gelu_tanh(y[i] + dco * u)); } }
    }
    if (hh == 0) { F.out[O_S5RP + (size_t)(b * S5G + g) * S5P + p] = car; F.out[O_S5IP + (size_t)(b * S5G + g) * S5P + p] = cai; }
    __syncthreads();
}

constexpr int GS_QE = 0, GS_KE = 2048, GS_KD = 4096, GS_DEC = 6144, GS_A = 6656, GS_V = 6784, GS_OP = 10880, GS_RED = 43648;
__device__ __forceinline__ void gla_sample_unit(Frame& F, int bs, int h) {
    LAS unsigned char* lds = F.lds; const int tid = F.tid, lane = F.lane, w = F.wave;
    const int row0 = R_PROMPT + bs * DECS;
    LAS float* QE = (LAS float*)(lds + GS_QE); LAS float* KE = (LAS float*)(lds + GS_KE); LAS float* KD = (LAS float*)(lds + GS_KD); LAS float* DEC = (LAS float*)(lds + GS_DEC);
    LAS float* AS = (LAS float*)(lds + GS_A); LAS float* VS = (LAS float*)(lds + GS_V); LAS float* OP = (LAS float*)(lds + GS_OP); LAS float* RED = (LAS float*)(lds + GS_RED);
    if (tid < 128) { const int d = tid; float bsum = 0.f, bt[4], q[4], k[4];
#pragma unroll
        for (int t = 0; t < 4; ++t) { float x = F.in[I_GB][h * 128 + d];
#pragma unroll
            for (int j = 0; j < 16; ++j) x += F.GLR[(size_t)(row0 + t) * 16 + j] * F.in[I_GUP][j * 512 + h * 128 + d];
            bsum += log_sigmoid(x) * (1.0f / 16.0f); bt[t] = bsum;
            q[t] = bf2f(F.Z[(size_t)(row0 + t) * ZC + ZQ + h * 128 + d]); k[t] = bf2f(F.Z[(size_t)(row0 + t) * ZC + ZK + h * 128 + d]); }
#pragma unroll
        for (int t = 0; t < 4; ++t) { QE[t * 128 + d] = q[t] * __expf(bt[t]); KE[t * 128 + d] = k[t] * __expf(-bt[t]); KD[t * 128 + d] = k[t] * __expf(bsum - bt[t]); }
        DEC[d] = __expf(bsum); }
    for (int i = tid; i < 4 * 256; i += 512) VS[i] = bf2f(F.Z[(size_t)(row0 + (i >> 8)) * ZC + ZV + h * 256 + (i & 255)]);
    __syncthreads();
    if (tid < 16) { const int t = tid >> 2, s = tid & 3; float a = 0.f; if (s <= t) { for (int d = 0; d < 128; ++d) a += QE[t * 128 + d] * KE[s * 128 + d]; } AS[tid] = a; }
    const float* s0 = F.in[I_SGLA] + ((size_t)(bs * NH + h) * DK) * DV; float* s1 = F.out + O_GLAS + ((size_t)(bs * NH + h) * DK) * DV;
    f32x4 v4[4], op[4];
#pragma unroll
    for (int t = 0; t < 4; ++t) { v4[t] = *(const LAS f32x4*)(VS + t * 256 + 4 * lane); op[t] = (f32x4){0.f, 0.f, 0.f, 0.f}; }
#pragma unroll 4
    for (int i = 0; i < 16; ++i) { const int d = 16 * w + i; const f32x4 s = *(const f32x4*)(s0 + (size_t)d * DV + 4 * lane); f32x4 sn = s * DEC[d];
#pragma unroll
        for (int t = 0; t < 4; ++t) { op[t] += s * QE[t * 128 + d]; sn += v4[t] * KD[t * 128 + d]; }
        *(f32x4*)(s1 + (size_t)d * DV + 4 * lane) = sn; }
#pragma unroll
    for (int t = 0; t < 4; ++t) *(LAS f32x4*)(OP + (w * 4 + t) * 256 + 4 * lane) = op[t];
    __syncthreads();
    { const int t = tid >> 7, e = 2 * (tid & 127); float o0 = 0.f, o1 = 0.f;
#pragma unroll
      for (int ww = 0; ww < 8; ++ww) { const f32x2 pv = *(const LAS f32x2*)(OP + (ww * 4 + t) * 256 + e); o0 += pv.x; o1 += pv.y; }
#pragma unroll
      for (int s = 0; s < 4; ++s) { const float a = AS[t * 4 + s]; o0 += a * VS[s * 256 + e]; o1 += a * VS[s * 256 + e + 1]; }
      float ss = wave_sum(o0 * o0 + o1 * o1);
      if (lane == 0) RED[w] = ss;
      __syncthreads();
      ss = RED[2 * t] + RED[2 * t + 1];
      const float rs = __builtin_amdgcn_rsqf(ss * (1.0f / 256.0f) + EPS);
      unsigned* zp = (unsigned*)(F.Z + (size_t)(row0 + t) * ZC + ZR + h * 256 + e); const unsigned rw = *zp;
      *zp = pk2(o0 * rs * bflo(rw), o1 * rs * bfhi(rw)); }
    __syncthreads();
}

__device__ __forceinline__ void s5_sample_unit(Frame& F, int bs) {
    LAS unsigned char* lds = F.lds; const int lane = F.lane, w = F.wave; const int row0 = R_PROMPT + bs * DECS;
    LAS float* US = (LAS float*)(lds + w * 4096);
    LAS float* HS = (LAS float*)(lds + w * 4096 + 256);
    for (int gg = 0; gg < 8; ++gg) { const int g = 8 * w + gg, p = lane;
        { const int t = lane >> 4, c = lane & 15; US[lane] = bf2f(F.Z[(size_t)(row0 + t) * ZC + ZU + 16 * g + c]); }
        const float are = F.ABAR[2 * (g * 64 + p)], aim = F.ABAR[2 * (g * 64 + p) + 1];
        float bre[16], bim[16];
#pragma unroll
        for (int c4 = 0; c4 < 4; ++c4) { const f32x4 x = *(const f32x4*)(F.BBAR + (size_t)(g * 64 + p) * 32 + 4 * c4), y = *(const f32x4*)(F.BBAR + (size_t)(g * 64 + p) * 32 + 16 + 4 * c4);
#pragma unroll
            for (int q = 0; q < 4; ++q) { bre[4 * c4 + q] = x[q]; bim[4 * c4 + q] = y[q]; } }
        float hr = F.in[I_S5RE][(size_t)(bs * S5G + g) * S5P + p], hi = F.in[I_S5IM][(size_t)(bs * S5G + g) * S5P + p];
        LDS_WAIT(); asm volatile("" ::: "memory");
#pragma unroll
        for (int t = 0; t < 4; ++t) { float ur = 0.f, ui = 0.f;
#pragma unroll
            for (int c = 0; c < 16; ++c) { const float u = US[t * 16 + c]; ur += bre[c] * u; ui += bim[c] * u; }
            const float nr = are * hr - aim * hi + ur, ni = are * hi + aim * hr + ui; hr = nr; hi = ni; HS[t * 128 + p] = hr; HS[t * 128 + 64 + p] = hi; }
        F.out[O_S5RS + (size_t)(bs * S5G + g) * S5P + p] = hr; F.out[O_S5IS + (size_t)(bs * S5G + g) * S5P + p] = hi;
        LDS_WAIT(); asm volatile("" ::: "memory");
        { const int t = lane >> 4, c = lane & 15; const float* cre = F.in[I_CRE] + (size_t)(g * 16 + c) * 64; const float* cim = F.in[I_CIM] + (size_t)(g * 16 + c) * 64; float y = 0.f;
#pragma unroll 4
          for (int p4 = 0; p4 < 16; ++p4) { const f32x4 a = *(const f32x4*)(cre + 4 * p4), bq = *(const f32x4*)(cim + 4 * p4);
              const f32x4 xr = *(const LAS f32x4*)(HS + t * 128 + 4 * p4), xi = *(const LAS f32x4*)(HS + t * 128 + 64 + 4 * p4);
              y += (a[0] * xr[0] + a[1] * xr[1] + a[2] * xr[2] + a[3] * xr[3]) - (bq[0] * xi[0] + bq[1] * xi[1] + bq[2] * xi[2] + bq[3] * xi[3]); }
          y += F.in[I_S5D][g * 16 + c] * US[lane];
          F.Z[(size_t)(row0 + t) * ZC + ZU + 16 * g + c] = (bf16_t)f2bf(gelu_tanh(y)); }
        LDS_WAIT(); asm volatile("" ::: "memory");
    }
}

__device__ __forceinline__ void p4a_prep(Frame& F) {
    for (int u = F.bid; u < 1028; u += F.G) { if (u < 1024) gla_prep_unit(F, u >> 7, (u >> 5) & 3, u & 31); else gla_meta_unit(F, u - 1024); }
}
__device__ __forceinline__ void p4_mixers(Frame& F, int kinds) {
    const int bid = F.bid, G = F.G;
    if (bid < 32) { if (kinds & 1) gla_seq_unit(F, bid >> 2, bid & 3); }
    else if (bid < 160) { if (kinds & 2) s5_prompt_unit(F, (bid - 32) >> 4, (bid - 32) & 15); }
    else { const int nb = G - 160;
        for (int u = bid - 160; u < 640; u += nb) { if (u < 512) { if (kinds & 4) gla_sample_unit(F, u >> 2, u & 3); } else { if (kinds & 8) s5_sample_unit(F, u - 512); } } }
}

constexpr int N_PHASES = 11;
__global__ void __launch_bounds__(512, 2) mk_fwd(Args args) {
    extern __shared__ __attribute__((aligned(16))) unsigned char lds_raw[];
    Frame F;
    F.lds = (LAS unsigned char*)lds_raw;
    F.tid = threadIdx.x; F.lane = F.tid & 63; F.wave = __builtin_amdgcn_readfirstlane(F.tid >> 6); F.G = gridDim.x; F.bid = blockIdx.x;
    F.in = args.in; F.out = args.out; F.ws = args.ws;
    F.H = args.out; F.XB = (bf16_t*)(args.out + O_GLAS); F.XB2 = (bf16_t*)(args.ws + WS_REGB); F.HID = (bf16_t*)(args.ws + WS_REGA); F.Z = (bf16_t*)(args.ws + WS_REGA); F.GT = (bf16_t*)(args.ws + WS_REGB);
    F.SSQ = (float*)(args.ws + WS_SSQ); F.GLR = (float*)(args.ws + WS_GLR); F.ABAR = (float*)(args.ws + WS_ABAR); F.BBAR = (float*)(args.ws + WS_BBAR);
    volatile LAS unsigned* MISC = (volatile LAS unsigned*)(F.lds + MISC_OFF);
    for (int u = F.tid; u < (LDS_BYTES - MISC_OFF) / 4; u += 512) MISC[u] = 0u;
    __syncthreads();
    XcdBarrier bar; bar.bar = (unsigned*)(args.ws + WS_CTL) + CW_BAR; bar.x = 0; bar.st = nullptr;
    const int lo = args.ph_lo, hi = args.ph_hi;
    if (hi - lo > 1) bar = xcd_barrier_post((unsigned*)(args.ws + WS_CTL) + CW_BAR, MISC + 8);
#ifndef PHM
#define PHM 0x7ff
#endif
#define IN(k) (((PHM >> (k)) & 1) && lo <= (k) && (k) < hi)
#define SEAM(k) do { if (IN(k) && IN((k) + 1)) xcd_barrier(bar); } while (0)
#ifndef REPM
#define REPM 0
#endif
#define REPS(k) _Pragma("unroll") for (int rep_ = 0; rep_ <= ((REPM >> (k)) & 1); ++rep_, (void)(rep_ <= ((REPM >> (k)) & 1) ? (xcd_barrier(bar), 0) : 0))
    const bf16_t* WT1 = (const bf16_t*)(args.ws + WS_WT1); const bf16_t* WD1 = (const bf16_t*)(args.ws + WS_WD1); const bf16_t* WIN = (const bf16_t*)(args.ws + WS_WIN); const bf16_t* WGO = (const bf16_t*)(args.ws + WS_WGO);
    const bf16_t* WGLU = (const bf16_t*)(args.ws + WS_WGLU); const bf16_t* WO = (const bf16_t*)(args.ws + WS_WO); const bf16_t* WT2 = (const bf16_t*)(args.ws + WS_WT2); const bf16_t* WD2 = (const bf16_t*)(args.ws + WS_WD2);

    if (IN(0)) REPS(0) { p0_prologue(F); } SEAM(0);
    if (IN(1)) REPS(1) {
        pg8::Gemm g{F.XB, WT1, R_PAD, 5632, D, D}; pg8::StaticOrder S; S.init(R_PAD, 5632, F.G, F.bid);
        pg8::EpiGU E{F.HID, FF, F.SSQ}; pg8::gemm_phase(F.lds, g, S, E); } SEAM(1);
    if (IN(2)) REPS(2) {
        pg8::Gemm g{F.HID, WD1, R_PAD, D, FF, FF}; pg8::StaticOrder S; S.init(R_PAD, D, F.G, F.bid);
        pg8::EpiRes E{0, F.in[I_XP], F.in[I_XS], F.in[I_META], F.H, F.XB, F.SSQ, 0.5f}; pg8::gemm_phase(F.lds, g, S, E); } SEAM(2);
    if (IN(3)) REPS(3) {
        pg8::Gemm g{F.XB, WIN, R_PAD, NWIN, D, D}; pg8::StaticOrder S; S.init(R_PAD, NWIN, F.G, F.bid);
        pg8::EpiZ E{F.Z, F.GT, F.GLR, F.SSQ}; pg8::gemm_phase(F.lds, g, S, E); } SEAM(3);
#ifndef P4SPLIT
#define P4SPLIT 0
#endif
    if (IN(4)) { p4a_prep(F); xcd_barrier(bar); if (P4SPLIT) { p4_mixers(F, P4SPLIT); xcd_barrier(bar); p4_mixers(F, 15 ^ P4SPLIT); } else p4_mixers(F, 15); } SEAM(4);
    if (IN(5)) REPS(5) {
        pg8::Gemm g{F.Z + ZU, WGLU, R_TOK, 2048, D, ZC}; pg8::StaticOrder S; S.init(R_TOK, 2048, F.G, F.bid);
        pg8::EpiGLU E{F.GT, F.Z}; pg8::gemm_phase(F.lds, g, S, E); } SEAM(5);
    if (IN(6)) REPS(6) {
        pg8::Gemm g{F.Z + ZR, WGO, R_TOK, D, D, ZC}; pg8::StaticOrder S; S.init(R_TOK, D, F.G, F.bid);
        pg8::EpiGO E{F.GT, F.Z, F.Z + 1024}; pg8::gemm_phase(F.lds, g, S, E); } SEAM(6);
    if (IN(7)) REPS(7) {
        pg8::Gemm g{F.Z + 1024, WO, R_TOK, D, D, ZC}; pg8::StaticOrder S; S.init(R_TOK, D, F.G, F.bid);
        pg8::EpiRes E{1, nullptr, nullptr, nullptr, F.H, F.XB2, F.SSQ, 1.0f}; pg8::gemm_phase(F.lds, g, S, E); } SEAM(7);
    if (IN(8)) REPS(8) {
        pg8::Gemm g{F.XB2, WT2, R_TOK, 5632, D, D}; pg8::StaticOrder S; S.init(R_TOK, 5632, F.G, F.bid);
        pg8::EpiGU E{F.HID, FF, F.SSQ}; pg8::gemm_phase(F.lds, g, S, E); } SEAM(8);
    if (IN(9)) REPS(9) {
        pg8::Gemm g{F.HID, WD2, R_TOK, D, FF, FF}; pg8::StaticOrder S; S.init(R_TOK, D, F.G, F.bid);
        pg8::EpiRes E{1, nullptr, nullptr, nullptr, F.H, nullptr, F.SSQ, 0.5f}; pg8::gemm_phase(F.lds, g, S, E); } SEAM(9);
    if (IN(10)) { p10_final(F); }
#undef IN
#undef SEAM
}

extern "C" void kernel_launch(void* const* d_in, const int* in_sizes, int n_in, void* d_out, int out_size, void* d_ws, size_t ws_size, hipStream_t stream) {
    static int grid = 0;
    if (grid == 0) {
        if (n_in != 32 || (size_t)out_size != O_END || ws_size < WS_END) { fprintf(stderr, "kernel_launch: unexpected shapes: n_in %d out %d ws %zu (need %zu)\n", n_in, out_size, ws_size, (size_t)WS_END); grid = -1; return; }
        int dev = 0, cus = 0, per_cu = 0;
        if (hipGetDevice(&dev) != hipSuccess || hipDeviceGetAttribute(&cus, hipDeviceAttributeMultiprocessorCount, dev) != hipSuccess) { grid = -1; return; }
        if (hipFuncSetAttribute((const void*)mk_fwd, hipFuncAttributeMaxDynamicSharedMemorySize, LDS_BYTES) != hipSuccess) { fprintf(stderr, "kernel_launch: hipFuncSetAttribute failed\n"); grid = -1; return; }
        if (hipOccupancyMaxActiveBlocksPerMultiprocessor(&per_cu, (const void*)mk_fwd, 512, LDS_BYTES) != hipSuccess || per_cu < 1) { fprintf(stderr, "kernel_launch: occupancy query says %d\n", per_cu); per_cu = 1; }
        (void)hipGetLastError();
        grid = cus;
    }
    if (grid < 0) return;
    (void)hipMemsetAsync((char*)d_ws + WS_CTL, 0, CTL_ZERO_BYTES, stream);
    Args a{};
    for (int i = 0; i < 32; ++i) a.in[i] = (const float*)d_in[i];
    a.out = (float*)d_out; a.ws = (unsigned char*)d_ws;
#if MK_PER_PHASE
    for (int p = 0; p < N_PHASES; ++p) { a.ph_lo = p; a.ph_hi = p + 1; hipLaunchKernelGGL(mk_fwd, dim3(grid), dim3(512), LDS_BYTES, stream, a); }
#else
    a.ph_lo = 0; a.ph_hi = N_PHASES;
    void* kargs[] = {&a};
    hipError_t e = hipLaunchCooperativeKernel((const void*)mk_fwd, dim3(grid), dim3(512), kargs, LDS_BYTES, stream);
    if (e != hipSuccess) fprintf(stderr, "kernel_launch: cooperative launch failed: %s (grid %d)\n", hipGetErrorString(e), grid);
#endif
}
```
